# Optimizing an MI355X kernel written in HIP

```python
import math
import jax, jax.numpy as jnp
from jax import lax
import numpy as np

D_MODEL = 1024
BATCH = 32
SEQ = 2048
DEPTH = 2

GRID_W = 64
CTX_LEN = 256
EPS = 1e-6

NA_HEADS = 8
NA_HEAD_DIM = 64
NA_WIDTH = NA_HEADS * NA_HEAD_DIM
NA_WIN_H = 8
NA_WIN_W = 16
NA_COL_BLOCK = 16
NA_KEY_COLS = 2 * NA_WIN_W
NA_SCALE = NA_HEAD_DIM ** -0.5

MLA_HEADS = 8
MLA_NOPE_DIM = 64
MLA_ROPE_DIM = 32
MLA_V_DIM = 64
MLA_WIDTH = MLA_HEADS * MLA_V_DIM
MLA_Q_RANK = 256
MLA_KV_RANK = 128
MLA_Q_BLOCK = 128
MLA_SCALE = (MLA_NOPE_DIM + MLA_ROPE_DIM) ** -0.5
ROPE_THETA = 10000.0

D_MIX = NA_WIDTH + MLA_WIDTH
IN_SPLITS = (NA_WIDTH, NA_WIDTH, NA_WIDTH, NA_WIDTH,
             MLA_Q_RANK, MLA_KV_RANK, MLA_ROPE_DIM, MLA_WIDTH)
D_IN = sum(IN_SPLITS)

kernel_name = "hybrid_natten_mla_dit_prefix"


def rmsnorm(x, g):
    xf = x.astype(jnp.float32)
    y = xf * lax.rsqrt(jnp.mean(xf * xf, axis=-1, keepdims=True) + EPS)
    return (y * g.astype(jnp.float32)).astype(x.dtype)


def axial_rope_tables(n_tokens):
    t = jnp.arange(n_tokens)
    row = (t // GRID_W).astype(jnp.float32)
    col = (t % GRID_W).astype(jnp.float32)
    per_axis = MLA_ROPE_DIM // 2
    inv = 1.0 / (ROPE_THETA ** (jnp.arange(0, per_axis, 2, dtype=jnp.float32) / per_axis))
    ang = jnp.concatenate([row[:, None] * inv[None], col[:, None] * inv[None]], axis=-1)
    return jnp.cos(ang), jnp.sin(ang)


def apply_rope(x, cos, sin):
    xp = x.reshape(x.shape[:-1] + (MLA_ROPE_DIM // 2, 2))
    x1, x2 = xp[..., 0], xp[..., 1]
    bshape = (cos.shape[0],) + (1,) * (x.ndim - 3) + (cos.shape[1],)
    cs = cos.reshape(bshape).astype(x.dtype)
    sn = sin.reshape(bshape).astype(x.dtype)
    return jnp.stack([x1 * cs - x2 * sn, x1 * sn + x2 * cs], axis=-1).reshape(x.shape)


def project(h, w_in, q_norm_g, w_uq, kv_norm_g, w_ukv):
    B, T, _ = h.shape
    cuts = [int(i) for i in np.cumsum(IN_SPLITS)[:-1]]
    na_q, na_k, na_v, na_gate, c_q, c_kv, k_rope, mla_gate = jnp.split(h @ w_in, cuts, axis=-1)
    na_q = na_q.reshape(B, T, NA_HEADS, NA_HEAD_DIM)
    na_k = na_k.reshape(B, T, NA_HEADS, NA_HEAD_DIM)
    na_v = na_v.reshape(B, T, NA_HEADS, NA_HEAD_DIM)
    q = (rmsnorm(c_q, q_norm_g) @ w_uq).reshape(B, T, MLA_HEADS, MLA_NOPE_DIM + MLA_ROPE_DIM)
    q_nope, q_rope = q[..., :MLA_NOPE_DIM], q[..., MLA_NOPE_DIM:]
    kv = (rmsnorm(c_kv, kv_norm_g) @ w_ukv).reshape(B, T, MLA_HEADS, MLA_NOPE_DIM + MLA_V_DIM)
    k_nope, mla_v = kv[..., :MLA_NOPE_DIM], kv[..., MLA_NOPE_DIM:]
    return na_q, na_k, na_v, na_gate, q_nope, q_rope, k_nope, k_rope, mla_v, mla_gate


def dense_attention(q, k, v, scale):
    s = jnp.einsum('bqhd,bkhd->bhqk', q, k).astype(jnp.float32) * scale
    p = jax.nn.softmax(s, axis=-1)
    return jnp.einsum('bhqk,bkhd->bqhd', p.astype(v.dtype), v)


def neighbourhood_attention(q, k, v, k_ctx, v_ctx, rpb):
    B, S, H, D = q.shape
    rows = S // GRID_W
    wh = min(NA_WIN_H, rows)
    n_cb = GRID_W // NA_COL_BLOCK
    qg = q.reshape(B, rows, n_cb, NA_COL_BLOCK, H, D)
    kg = k.reshape(B, rows, GRID_W, H, D)
    vg = v.reshape(B, rows, GRID_W, H, D)
    q_cols = np.arange(GRID_W).reshape(n_cb, NA_COL_BLOCK)
    q_cs = np.clip(q_cols - NA_WIN_W // 2, 0, GRID_W - NA_WIN_W)
    cb_start = np.clip(np.arange(n_cb) * NA_COL_BLOCK - NA_WIN_W // 2, 0, GRID_W - NA_KEY_COLS)
    key_cols = cb_start[:, None] + np.arange(NA_KEY_COLS)[None]
    kc = key_cols[:, None, :]
    col_mask = (kc >= q_cs[:, :, None]) & (kc < q_cs[:, :, None] + NA_WIN_W)
    dcol = np.clip(kc - q_cols[:, :, None] + NA_WIN_W - 1, 0, 2 * NA_WIN_W - 2)
    bias_col = rpb[:, :, dcol]
    n_loc = wh * NA_KEY_COLS

    def row_block(r):
        rs = jnp.clip(r - wh // 2, 0, rows - wh)
        q_r = lax.dynamic_index_in_dim(qg, r, axis=1, keepdims=False)
        k_r = lax.dynamic_slice_in_dim(kg, rs, wh, axis=1)
        v_r = lax.dynamic_slice_in_dim(vg, rs, wh, axis=1)
        k_w = k_r[:, :, key_cols]
        v_w = v_r[:, :, key_cols]
        s_loc = jnp.einsum('bjqhd,bwjkhd->bhjqwk', q_r, k_w).astype(jnp.float32) * NA_SCALE
        drow = rs + jnp.arange(wh) - r + NA_WIN_H - 1
        bias = jnp.take(bias_col, drow, axis=1).transpose(0, 2, 3, 1, 4)
        s_loc = s_loc + bias[None].astype(jnp.float32)
        s_loc = jnp.where(col_mask[None, None, :, :, None, :], s_loc, -1e30)
        s_ctx = jnp.einsum('bjqhd,bchd->bhjqc', q_r, k_ctx).astype(jnp.float32) * NA_SCALE
        s = jnp.concatenate([s_loc.reshape(B, H, n_cb, NA_COL_BLOCK, n_loc), s_ctx], axis=-1)
        p = jax.nn.softmax(s, axis=-1).astype(v.dtype)
        p_loc = p[..., :n_loc].reshape(B, H, n_cb, NA_COL_BLOCK, wh, NA_KEY_COLS)
        p_ctx = p[..., n_loc:]
        return (jnp.einsum('bhjqwk,bwjkhd->bjqhd', p_loc, v_w)
                + jnp.einsum('bhjqc,bchd->bjqhd', p_ctx, v_ctx))

    out = lax.map(row_block, jnp.arange(rows))
    return jnp.moveaxis(out, 0, 1).reshape(B, S, H, D)


def mla_attend(q_nope, q_rope, k_nope, k_rope, v):
    s = (jnp.einsum('bqhd,bkhd->bhqk', q_nope, k_nope)
         + jnp.einsum('bqhr,bkr->bhqk', q_rope, k_rope)).astype(jnp.float32) * MLA_SCALE
    p = jax.nn.softmax(s, axis=-1)
    return jnp.einsum('bhqk,bkhd->bqhd', p.astype(v.dtype), v)


def mla_latent(q_nope, q_rope, k_nope, k_rope, v, kc_nope, kc_rope, vc):
    B, S, H, _ = q_nope.shape
    nb = S // MLA_Q_BLOCK
    kn = jnp.concatenate([k_nope, kc_nope], axis=1)
    kr = jnp.concatenate([k_rope, kc_rope], axis=1)
    vv = jnp.concatenate([v, vc], axis=1)
    qn = q_nope.reshape(B, nb, MLA_Q_BLOCK, H, MLA_NOPE_DIM).swapaxes(0, 1)
    qr = q_rope.reshape(B, nb, MLA_Q_BLOCK, H, MLA_ROPE_DIM).swapaxes(0, 1)
    o = lax.map(lambda qs: mla_attend(qs[0], qs[1], kn, kr, vv), (qn, qr))
    return o.swapaxes(0, 1).reshape(B, S, H, MLA_V_DIM)


def hybrid_layer(x, ctx, c, c_ctx, norm_g, w_ada, b_ada, w_in, rpb, q_norm_g, w_uq,
                 kv_norm_g, w_ukv, w_out, cos, sin, update_ctx):
    B, S, D = x.shape
    shift, scale, gate = jnp.split(jax.nn.silu(c) @ w_ada + b_ada, 3, axis=-1)
    shift_c, scale_c, gate_c = jnp.split(jax.nn.silu(c_ctx) @ w_ada + b_ada, 3, axis=-1)
    hx = rmsnorm(x, norm_g) * (1.0 + scale[:, None]) + shift[:, None]
    hc = rmsnorm(ctx, norm_g) * (1.0 + scale_c) + shift_c

    (na_q, na_k, na_v, na_gate, q_nope, q_rope, k_nope, k_rope, mla_v, mla_gate) = project(
        hx, w_in, q_norm_g, w_uq, kv_norm_g, w_ukv)
    (cna_q, cna_k, cna_v, cna_gate, cq_nope, cq_rope, ck_nope, ck_rope, cmla_v, cmla_gate) = project(
        hc, w_in, q_norm_g, w_uq, kv_norm_g, w_ukv)
    q_rope = apply_rope(q_rope, cos, sin)
    k_rope = apply_rope(k_rope, cos, sin)

    na_out = neighbourhood_attention(na_q, na_k, na_v, cna_k, cna_v, rpb)
    mla_out = mla_latent(q_nope, q_rope, k_nope, k_rope, mla_v, ck_nope, ck_rope, cmla_v)
    y = jnp.concatenate([na_out.reshape(B, S, NA_WIDTH) * jax.nn.silu(na_gate),
                         mla_out.reshape(B, S, MLA_WIDTH) * jax.nn.silu(mla_gate)], axis=-1) @ w_out
    x = x + gate[:, None] * y

    if update_ctx:
        C = ctx.shape[1]
        cna_out = dense_attention(cna_q, cna_k, cna_v, NA_SCALE)
        cmla_out = mla_attend(cq_nope, cq_rope, ck_nope, ck_rope, cmla_v)
        yc = jnp.concatenate([cna_out.reshape(B, C, NA_WIDTH) * jax.nn.silu(cna_gate),
                              cmla_out.reshape(B, C, MLA_WIDTH) * jax.nn.silu(cmla_gate)], axis=-1) @ w_out
        ctx = ctx + gate_c * yc
    return x, ctx


def setup_inputs(seed: int = 0) -> dict:
    key = jax.random.key(seed)
    ks = jax.random.split(key, 16)
    f32 = jnp.float32
    nrm = lambda k, shape, s: jax.random.normal(k, shape, f32) * s
    return {
        "x": nrm(ks[0], (BATCH, SEQ, D_MODEL), 1.0),
        "c": nrm(ks[1], (BATCH, D_MODEL), 1.0),
        "ctx": nrm(ks[2], (BATCH, CTX_LEN, D_MODEL), 1.0),
        "c_ctx": nrm(ks[3], (D_MODEL,), 1.0),
        "norm_g": 1.0 + nrm(ks[4], (DEPTH, D_MODEL), 0.01),
        "w_ada": nrm(ks[5], (DEPTH, D_MODEL, 3 * D_MODEL), D_MODEL ** -0.5),
        "b_ada": nrm(ks[6], (DEPTH, 3 * D_MODEL), 0.01),
        "w_in": nrm(ks[7], (DEPTH, D_MODEL, D_IN), D_MODEL ** -0.5),
        "na_rpb": nrm(ks[8], (DEPTH, NA_HEADS, 2 * NA_WIN_H - 1, 2 * NA_WIN_W - 1), 0.1),
        "q_norm_g": 1.0 + nrm(ks[9], (DEPTH, MLA_Q_RANK), 0.01),
        "w_uq": nrm(ks[10], (DEPTH, MLA_Q_RANK, MLA_HEADS * (MLA_NOPE_DIM + MLA_ROPE_DIM)), MLA_Q_RANK ** -0.5),
        "kv_norm_g": 1.0 + nrm(ks[11], (DEPTH, MLA_KV_RANK), 0.01),
        "w_ukv": nrm(ks[12], (DEPTH, MLA_KV_RANK, MLA_HEADS * (MLA_NOPE_DIM + MLA_V_DIM)), MLA_KV_RANK ** -0.5),
        "w_out": nrm(ks[13], (DEPTH, D_MIX, D_MODEL), D_MIX ** -0.5),
        "final_norm_g": 1.0 + nrm(ks[14], (D_MODEL,), 0.01),
    }


def reference(x, c, ctx, c_ctx, norm_g, w_ada, b_ada, w_in, na_rpb, q_norm_g, w_uq,
              kv_norm_g, w_ukv, w_out, final_norm_g):
    cos, sin = axial_rope_tables(x.shape[1])
    for l in range(DEPTH):
        x, ctx = hybrid_layer(x, ctx, c, c_ctx, norm_g[l], w_ada[l], b_ada[l], w_in[l], na_rpb[l],
                              q_norm_g[l], w_uq[l], kv_norm_g[l], w_ukv[l], w_out[l], cos, sin,
                              update_ctx=(l < DEPTH - 1))
    return rmsnorm(x, final_norm_g)
```

```cpp
#include <hip/hip_runtime.h>
#include <hip/hip_cooperative_groups.h>
#include <cstdio>
namespace cg = cooperative_groups;

#ifndef MK_FUSED
#define MK_FUSED 0
#endif

#define DI __device__ __forceinline__
typedef __attribute__((ext_vector_type(8))) short bf16x8;
typedef __attribute__((ext_vector_type(16))) float f32x16;
typedef __bf16 bf16_2 __attribute__((ext_vector_type(2)));
typedef float float_2 __attribute__((ext_vector_type(2)));
typedef unsigned short u16;
#define MFMA32(a, b, c) __builtin_amdgcn_mfma_f32_32x32x16_bf16((a), (b), (c), 0, 0, 0)

constexpr int NB = 32, SEQ = 2048, CTX = 256, TPB = SEQ + CTX;
constexpr int MT = NB * TPB;
constexpr int DM = 1024, DIN = 2976, NPAD = 3072;
constexpr float LOG2E = 1.4426950408889634f;
constexpr float NA_QS = 0.125f * LOG2E;
constexpr float MLA_QS = 0.10206207261596575f * LOG2E;
constexpr float EPS = 1e-6f;
constexpr int NTHREADS = 256;
constexpr int LDS_BYTES = 66560;

constexpr size_t al256(size_t x) { return (x + 255) & ~(size_t)255; }
constexpr size_t WS_CTL = 0;
constexpr size_t WS_MOD = 65536;
constexpr size_t WS_ROPE = WS_MOD + al256((size_t)2 * 33 * 3072 * 4);
constexpr size_t WS_WIN = WS_ROPE + (size_t)2 * 2048 * 16 * 4;
constexpr size_t WS_WUQ = WS_WIN + (size_t)2 * NPAD * 1024 * 2;
constexpr size_t WS_WUKV = WS_WUQ + (size_t)2 * 768 * 256 * 2;
constexpr size_t WS_WOUT = WS_WUKV + (size_t)2 * 1024 * 128 * 2;
constexpr size_t WS_H = WS_WOUT + (size_t)2 * 1024 * 1024 * 2;
constexpr size_t WS_QNA = WS_H + (size_t)MT * 1024 * 2;
constexpr size_t WS_KNA = WS_QNA + (size_t)MT * 512 * 2;
constexpr size_t WS_VTNA = WS_KNA + (size_t)MT * 512 * 2;
constexpr size_t WS_GNA = WS_VTNA + (size_t)MT * 512 * 2;
constexpr size_t WS_GMLA = WS_GNA + (size_t)MT * 512 * 2;
constexpr size_t WS_CQ = WS_GMLA + (size_t)MT * 512 * 2;
constexpr size_t WS_CKV = WS_CQ + (size_t)MT * 256 * 2;
constexpr size_t WS_KR = WS_CKV + (size_t)MT * 128 * 2;
constexpr size_t WS_QMLA = WS_KR + (size_t)MT * 32 * 4;
constexpr size_t WS_KMLA = WS_QMLA + (size_t)MT * 768 * 2;
constexpr size_t WS_VTMLA = WS_KMLA + (size_t)MT * 768 * 2;
constexpr size_t WS_CTX1 = WS_VTMLA + (size_t)MT * 512 * 2;
constexpr size_t WS_END = WS_CTX1 + (size_t)NB * CTX * 1024 * 4;
static_assert(WS_END <= (size_t)1073741824, "workspace");

struct Params {
  const float *x, *c, *ctx, *c_ctx, *norm_g, *w_ada, *b_ada, *w_in, *rpb, *q_norm_g, *w_uq, *kv_norm_g, *w_ukv, *w_out, *final_g;
  float* out;
  unsigned char* ws;
};

DI unsigned pack2(float a, float b) { float_2 f = {a, b}; bf16_2 r = __builtin_convertvector(f, bf16_2); return __builtin_bit_cast(unsigned, r); }
DI float bf2f(unsigned v) { return __uint_as_float(v << 16); }
DI float bflo(unsigned v) { return __uint_as_float(v << 16); }
DI float bfhi(unsigned v) { return __uint_as_float(v & 0xffff0000u); }
DI uint4 ldg16(const void* p) { return *reinterpret_cast<const uint4*>(p); }
DI bf16x8 as_frag(uint4 v) { return __builtin_bit_cast(bf16x8, v); }
DI float silu(float v) { return v / (1.f + __expf(-v)); }
DI int kappa(int i) { return (i & 0x13) | ((i & 4) << 1) | ((i & 8) >> 1); }
DI float wave_sum(float v) {
#pragma unroll
  for (int o = 32; o >= 1; o >>= 1) v += __shfl_xor(v, o);
  return v;
}

DI int remap_in(int n) { return n < 2432 ? n : (n < 2464 ? 2944 + (n - 2432) : 2432 + (n - 2464)); }
DI void transpose_item(const float* __restrict__ src, int K, int N, u16* __restrict__ dst, int k0, int n0, float* tile, int mode, const float* __restrict__ g) {
  const int t = threadIdx.x;
  __syncthreads();
#pragma unroll 4
  for (int i = 0; i < 16; ++i) {
    const int kk = i * 4 + (t >> 6), nn = t & 63;
    float v = 0.f;
    if (n0 + nn < N) v = src[(size_t)(k0 + kk) * N + n0 + nn];
    if (mode == 2) v *= g[k0 + kk] * MLA_QS;
    if (mode == 3) v *= g[k0 + kk];
    if (mode == 0 && n0 + nn < 512) v *= NA_QS;
    tile[kk * 65 + nn] = v;
  }
  __syncthreads();
#pragma unroll 4
  for (int i = 0; i < 16; ++i) {
    const int nn = i * 4 + (t >> 6), kk = t & 63;
    const int n = n0 + nn;
    if (n < N) {
      const int nr = (mode == 0) ? remap_in(n) : (mode == 3 ? ((n & 64) ? 512 : 0) + (n >> 7) * 64 + (n & 63) : n);
      dst[(size_t)nr * K + k0 + kk] = (u16)(pack2(tile[kk * 65 + nn], 0.f) & 0xffffu);
    }
  }
}

DI void adaln_item(const Params& P, int l, int cc, float* sil) {
  const int t = threadIdx.x, kg = t >> 5, cl = t & 31, n0 = cc * 32;
  float acc[33];
#pragma unroll
  for (int r = 0; r < 33; ++r) acc[r] = 0.f;
  const float* W = P.w_ada + (size_t)l * 1024 * 3072;
  for (int kq = 0; kq < 4; ++kq) {
    __syncthreads();
    for (int idx = t; idx < 33 * 256; idx += NTHREADS) {
      const int r = idx >> 8, kk = idx & 255;
      const float v = (r < 32) ? P.c[r * 1024 + kq * 256 + kk] : P.c_ctx[kq * 256 + kk];
      sil[idx] = silu(v);
    }
    __syncthreads();
    for (int kk = kg * 32; kk < kg * 32 + 32; ++kk) {
      const float w = W[(size_t)(kq * 256 + kk) * 3072 + n0 + cl];
#pragma unroll
      for (int r = 0; r < 33; ++r) acc[r] += sil[r * 256 + kk] * w;
    }
  }
  __syncthreads();
#pragma unroll
  for (int r = 0; r < 33; ++r) sil[(kg * 33 + r) * 32 + cl] = acc[r];
  __syncthreads();
  float* MOD = reinterpret_cast<float*>(P.ws + WS_MOD) + (size_t)l * 33 * 3072;
  for (int idx = t; idx < 33 * 32; idx += NTHREADS) {
    const int r = idx >> 5, c2 = idx & 31;
    float s = 0.f;
#pragma unroll
    for (int k2 = 0; k2 < 8; ++k2) s += sil[(k2 * 33 + r) * 32 + c2];
    MOD[r * 3072 + n0 + c2] = s + P.b_ada[l * 3072 + n0 + c2];
  }
}

constexpr int P0_ADA = 2 * 96, P0_TR_IN = 16 * 47, P0_TR_OUT = 256, P0_TR_UQ = 48, P0_TR_UKV = 32;
constexpr int P0_TR_L = P0_TR_IN + P0_TR_OUT + P0_TR_UQ + P0_TR_UKV;
constexpr int P0_PAD = 2, P0_ROPE = 128;
constexpr int P0_ITEMS = P0_ADA + 2 * P0_TR_L + P0_PAD + P0_ROPE;

DI void phase0(const Params& P, char* lds, int bid, int nblk) {
  float* fl = reinterpret_cast<float*>(lds);
  const int t = threadIdx.x;
  for (int it = bid; it < P0_ITEMS; it += nblk) {
    int u = it;
    if (u < P0_ADA) { adaln_item(P, u / 96, u % 96, fl); continue; }
    u -= P0_ADA;
    if (u < 2 * P0_TR_L) {
      const int l = u / P0_TR_L; int v = u % P0_TR_L;
      if (v < P0_TR_IN) {
        transpose_item(P.w_in + (size_t)l * 1024 * DIN, 1024, DIN, reinterpret_cast<u16*>(P.ws + WS_WIN) + (size_t)l * NPAD * 1024, (v / 47) * 64, (v % 47) * 64, fl, 0, nullptr);
        continue;
      }
      v -= P0_TR_IN;
      if (v < P0_TR_OUT) {
        transpose_item(P.w_out + (size_t)l * 1024 * 1024, 1024, 1024, reinterpret_cast<u16*>(P.ws + WS_WOUT) + (size_t)l * 1024 * 1024, (v / 16) * 64, (v % 16) * 64, fl, 1, nullptr);
        continue;
      }
      v -= P0_TR_OUT;
      if (v < P0_TR_UQ) {
        transpose_item(P.w_uq + (size_t)l * 256 * 768, 256, 768, reinterpret_cast<u16*>(P.ws + WS_WUQ) + (size_t)l * 768 * 256, (v / 12) * 64, (v % 12) * 64, fl, 2, P.q_norm_g + l * 256);
        continue;
      }
      v -= P0_TR_UQ;
      transpose_item(P.w_ukv + (size_t)l * 128 * 1024, 128, 1024, reinterpret_cast<u16*>(P.ws + WS_WUKV) + (size_t)l * 1024 * 128, (v / 16) * 64, (v % 16) * 64, fl, 3, P.kv_norm_g + l * 128);
      continue;
    }
    u -= 2 * P0_TR_L;
    if (u < P0_PAD) {
      uint4* d = reinterpret_cast<uint4*>(reinterpret_cast<u16*>(P.ws + WS_WIN) + ((size_t)u * NPAD + DIN) * 1024);
      for (int i = t; i < 96 * 1024 / 8; i += NTHREADS) d[i] = make_uint4(0, 0, 0, 0);
      continue;
    }
    u -= P0_PAD;
    {
      const int idx = u * 256 + t, pos = idx >> 4, p = idx & 15, row = pos >> 6, col = pos & 63, i = p & 7;
      const float inv = 1.0f / powf(10000.0f, (float)(2 * i) / 16.0f);
      const float ang = (float)(p < 8 ? row : col) * inv;
      float* R = reinterpret_cast<float*>(P.ws + WS_ROPE);
      R[idx] = cosf(ang);
      R[2048 * 16 + idx] = sinf(ang);
    }
  }
}

DI void phase_norm(const Params& P, int layer, int bid, int nblk) {
  const int t = threadIdx.x, lane = t & 63, wave = __builtin_amdgcn_readfirstlane(t >> 6);
  const float* MOD = reinterpret_cast<const float*>(P.ws + WS_MOD) + (size_t)layer * 33 * 3072;
  const float* g = P.norm_g + layer * 1024;
  const float* xs = layer == 0 ? P.x : P.out;
  const float* cs = layer == 0 ? P.ctx : reinterpret_cast<const float*>(P.ws + WS_CTX1);
  u16* H = reinterpret_cast<u16*>(P.ws + WS_H);
  for (int row = bid * 4 + wave; row < MT; row += nblk * 4) {
    const int b = row / TPB, pos = row - b * TPB;
    const float* src = pos < SEQ ? xs + ((size_t)b * SEQ + pos) * 1024 : cs + ((size_t)b * CTX + (pos - SEQ)) * 1024;
    const float* md = MOD + (pos < SEQ ? b : 32) * 3072;
    float v[16];
#pragma unroll
    for (int q = 0; q < 2; ++q) {
      const float4 a = *reinterpret_cast<const float4*>(src + q * 512 + lane * 8);
      const float4 bq = *reinterpret_cast<const float4*>(src + q * 512 + lane * 8 + 4);
      v[q * 8 + 0] = a.x; v[q * 8 + 1] = a.y; v[q * 8 + 2] = a.z; v[q * 8 + 3] = a.w;
      v[q * 8 + 4] = bq.x; v[q * 8 + 5] = bq.y; v[q * 8 + 6] = bq.z; v[q * 8 + 7] = bq.w;
    }
    float ss = 0.f;
#pragma unroll
    for (int i = 0; i < 16; ++i) ss += v[i] * v[i];
    ss = wave_sum(ss);
    const float rstd = rsqrtf(ss * (1.f / 1024.f) + EPS);
#pragma unroll
    for (int q = 0; q < 2; ++q) {
      const int k = q * 512 + lane * 8;
      float o[8];
#pragma unroll
      for (int e = 0; e < 8; ++e) o[e] = v[q * 8 + e] * rstd * g[k + e] * (1.f + md[1024 + k + e]) + md[k + e];
      uint4 w;
      w.x = pack2(o[0], o[1]); w.y = pack2(o[2], o[3]); w.z = pack2(o[4], o[5]); w.w = pack2(o[6], o[7]);
      *reinterpret_cast<uint4*>(H + (size_t)row * 1024 + k) = w;
    }
  }
}

enum { EPI_INPROJ = 0, EPI_QPROJ = 1, EPI_KVPROJ = 2, EPI_OUTPROJ = 3 };

template <int EPI>
DI void epi_swapped(const Params& P, int layer, int m, int n, const float* v, float rs) {
  const int b = m / TPB, pos = m - b * TPB;
  if constexpr (EPI == EPI_INPROJ) {
    u16* dst; float o0 = v[0], o1 = v[1], o2 = v[2], o3 = v[3];
    if (n < 512) dst = reinterpret_cast<u16*>(P.ws + WS_QNA) + (size_t)m * 512 + n;
    else if (n < 1024) dst = reinterpret_cast<u16*>(P.ws + WS_KNA) + (size_t)m * 512 + (n - 512);
    else if (n < 2048) { dst = reinterpret_cast<u16*>(P.ws + WS_GNA) + (size_t)m * 512 + (n - 1536); o0 = silu(o0); o1 = silu(o1); o2 = silu(o2); o3 = silu(o3); }
    else if (n < 2304) dst = reinterpret_cast<u16*>(P.ws + WS_CQ) + (size_t)m * 256 + (n - 2048);
    else if (n < 2432) dst = reinterpret_cast<u16*>(P.ws + WS_CKV) + (size_t)m * 128 + (n - 2304);
    else if (n < 2944) { dst = reinterpret_cast<u16*>(P.ws + WS_GMLA) + (size_t)m * 512 + (n - 2432); o0 = silu(o0); o1 = silu(o1); o2 = silu(o2); o3 = silu(o3); }
    else if (n < 2976) { *reinterpret_cast<float4*>(reinterpret_cast<float*>(P.ws + WS_KR) + (size_t)m * 32 + (n - 2944)) = make_float4(o0, o1, o2, o3); return; }
    else return;
    *reinterpret_cast<uint2*>(dst) = make_uint2(pack2(o0, o1), pack2(o2, o3));
  } else if constexpr (EPI == EPI_QPROJ) {
    float o0 = v[0] * rs, o1 = v[1] * rs, o2 = v[2] * rs, o3 = v[3] * rs;
    const int dd = n % 96;
    if (dd >= 64 && pos < SEQ) {
      const float* R = reinterpret_cast<const float*>(P.ws + WS_ROPE);
      const int p0 = (dd - 64) >> 1;
      const float c0 = R[pos * 16 + p0], s0 = R[2048 * 16 + pos * 16 + p0], c1 = R[pos * 16 + p0 + 1], s1 = R[2048 * 16 + pos * 16 + p0 + 1];
      const float a0 = o0 * c0 - o1 * s0, a1 = o0 * s0 + o1 * c0, a2 = o2 * c1 - o3 * s1, a3 = o2 * s1 + o3 * c1;
      o0 = a0; o1 = a1; o2 = a2; o3 = a3;
    }
    *reinterpret_cast<uint2*>(reinterpret_cast<u16*>(P.ws + WS_QMLA) + (size_t)m * 768 + n) = make_uint2(pack2(o0, o1), pack2(o2, o3));
  } else if constexpr (EPI == EPI_KVPROJ) {
    const int hh = n >> 6, e = n & 63;
    u16* dst = reinterpret_cast<u16*>(P.ws + WS_KMLA) + (((size_t)b * 8 + hh) * TPB + pos) * 96 + e;
    *reinterpret_cast<uint2*>(dst) = make_uint2(pack2(v[0] * rs, v[1] * rs), pack2(v[2] * rs, v[3] * rs));
  } else {
    const float* MOD = reinterpret_cast<const float*>(P.ws + WS_MOD) + (size_t)layer * 33 * 3072;
    const float4 gt = *reinterpret_cast<const float4*>(MOD + (pos < SEQ ? b : 32) * 3072 + 2048 + n);
    const float* src; float* dst;
    if (pos < SEQ) { const size_t o = ((size_t)b * SEQ + pos) * 1024 + n; src = (layer == 0 ? P.x : P.out) + o; dst = P.out + o; }
    else { const size_t o = ((size_t)b * CTX + (pos - SEQ)) * 1024 + n; src = P.ctx + o; dst = reinterpret_cast<float*>(P.ws + WS_CTX1) + o; }
    const float4 xv = *reinterpret_cast<const float4*>(src);
    *reinterpret_cast<float4*>(dst) = make_float4(xv.x + gt.x * v[0], xv.y + gt.y * v[1], xv.z + gt.z * v[2], xv.w + gt.w * v[3]);
  }
}

template <int EPI>
DI void epi_natural(const Params& P, int m, int n, const float* v, const float* rsv) {
  const int b = m / TPB, pos = m - b * TPB;
  if constexpr (EPI == EPI_INPROJ) {
    const int vc = n - 1024, hh = vc >> 6, d = vc & 63;
    u16* dst = reinterpret_cast<u16*>(P.ws + WS_VTNA) + (((size_t)b * 8 + hh) * 64 + d) * TPB + pos;
    *reinterpret_cast<uint2*>(dst) = make_uint2(pack2(v[0], v[1]), pack2(v[2], v[3]));
  } else {
    const int hh = (n - 512) >> 6, d = n & 63;
    u16* dst = reinterpret_cast<u16*>(P.ws + WS_VTMLA) + (((size_t)b * 8 + hh) * 64 + d) * TPB + pos;
    *reinterpret_cast<uint2*>(dst) = make_uint2(pack2(v[0] * rsv[0], v[1] * rsv[1]), pack2(v[2] * rsv[2], v[3] * rsv[3]));
  }
}

template <int EPI, bool ROWNORM, bool NAT>
DI void gemm_tile(const Params& P, int layer, char* lds, const u16* __restrict__ A, int lda, const u16* __restrict__ Bt, int ldb, int K, int m0, int n0) {
  const int t = threadIdx.x, lane = t & 63, wave = __builtin_amdgcn_readfirstlane(t >> 6), wm = wave >> 1, wn = wave & 1;
  const int l31 = lane & 31, h = lane >> 5;
  const int ld_row = t >> 3, ld_chk = t & 7;
  const unsigned st_off = ld_row * 128 + ((ld_chk ^ ((ld_row >> 1) & 7)) << 4);
  const int swz = (l31 >> 1) & 7;
  const unsigned a_off = (wm * 64 + l31) * 128, b_off = (wn * 64 + l31) * 128;
  float* rstd_s = reinterpret_cast<float*>(lds + 65536);


  const u16* gA = A + (size_t)(m0 + ld_row) * lda + ld_chk * 8;
  const u16* gB = Bt + (size_t)(n0 + ld_row) * ldb + ld_chk * 8;
  uint4 ra[4], rb[4];
  float ss[4] = {0.f, 0.f, 0.f, 0.f};
  f32x16 acc[2][2];
#pragma unroll
  for (int i = 0; i < 2; ++i)
#pragma unroll
    for (int j = 0; j < 2; ++j)
#pragma unroll
      for (int r = 0; r < 16; ++r) acc[i][j][r] = 0.f;

  const int KT = K / 64;
#pragma unroll
  for (int i = 0; i < 4; ++i) { ra[i] = ldg16(gA + (size_t)i * 32 * lda); rb[i] = ldg16(gB + (size_t)i * 32 * ldb); }
  for (int kt = 0; kt < KT; ++kt) {
    char* bufA = lds + (kt & 1) * 16384;
    char* bufB = lds + 32768 + (kt & 1) * 16384;
#pragma unroll
    for (int i = 0; i < 4; ++i) {
      *reinterpret_cast<uint4*>(bufA + st_off + i * 4096) = ra[i];
      *reinterpret_cast<uint4*>(bufB + st_off + i * 4096) = rb[i];
    }
    if constexpr (ROWNORM) {
#pragma unroll
      for (int i = 0; i < 4; ++i) {
        const unsigned w4[4] = {ra[i].x, ra[i].y, ra[i].z, ra[i].w};
#pragma unroll
        for (int e = 0; e < 4; ++e) { const float lo = bflo(w4[e]), hi = bfhi(w4[e]); ss[i] += lo * lo + hi * hi; }
      }
    }
    __syncthreads();
    if (kt + 1 < KT) {
#pragma unroll
      for (int i = 0; i < 4; ++i) { ra[i] = ldg16(gA + (size_t)i * 32 * lda + (kt + 1) * 64); rb[i] = ldg16(gB + (size_t)i * 32 * ldb + (kt + 1) * 64); }
    }
#pragma unroll
    for (int ks = 0; ks < 4; ++ks) {
      const unsigned co = ((ks * 2 + h) ^ swz) << 4;
      bf16x8 af[2], bfr[2];
#pragma unroll
      for (int i = 0; i < 2; ++i) {
        af[i] = as_frag(*reinterpret_cast<const uint4*>(bufA + a_off + i * 4096 + co));
        bfr[i] = as_frag(*reinterpret_cast<const uint4*>(bufB + b_off + i * 4096 + co));
      }
      if constexpr (NAT) {
#pragma unroll
        for (int i = 0; i < 2; ++i)
#pragma unroll
          for (int j = 0; j < 2; ++j) acc[i][j] = MFMA32(af[i], bfr[j], acc[i][j]);
      } else {
#pragma unroll
        for (int i = 0; i < 2; ++i)
#pragma unroll
          for (int j = 0; j < 2; ++j) acc[i][j] = MFMA32(bfr[j], af[i], acc[i][j]);
      }
    }
  }
  if constexpr (ROWNORM) {
#pragma unroll
    for (int i = 0; i < 4; ++i) {
      float s = ss[i];
      s += __shfl_xor(s, 1); s += __shfl_xor(s, 2); s += __shfl_xor(s, 4);
      if (ld_chk == 0) rstd_s[ld_row + 32 * i] = rsqrtf(s / (float)K + EPS);
    }
  }
  __syncthreads();

#pragma unroll
  for (int i = 0; i < 2; ++i)
#pragma unroll
    for (int j = 0; j < 2; ++j) {
      if constexpr (!NAT) {
        const int ml = wm * 64 + i * 32 + l31;
        float rs = 1.f;
        if constexpr (ROWNORM) rs = rstd_s[ml];
#pragma unroll
        for (int g = 0; g < 4; ++g) {
          const float v[4] = {acc[i][j][4 * g], acc[i][j][4 * g + 1], acc[i][j][4 * g + 2], acc[i][j][4 * g + 3]};
          epi_swapped<EPI>(P, layer, m0 + ml, n0 + wn * 64 + j * 32 + 8 * g + 4 * h, v, rs);
        }
      } else {
        if constexpr (EPI == EPI_INPROJ || EPI == EPI_KVPROJ) {
#pragma unroll
          for (int g = 0; g < 4; ++g) {
            const int ml = wm * 64 + i * 32 + 8 * g + 4 * h;
            const float v[4] = {acc[i][j][4 * g], acc[i][j][4 * g + 1], acc[i][j][4 * g + 2], acc[i][j][4 * g + 3]};
            float rsv[4] = {1.f, 1.f, 1.f, 1.f};
            if constexpr (ROWNORM) { rsv[0] = rstd_s[ml]; rsv[1] = rstd_s[ml + 1]; rsv[2] = rstd_s[ml + 2]; rsv[3] = rstd_s[ml + 3]; }
            epi_natural<EPI>(P, m0 + ml, n0 + wn * 64 + j * 32 + l31, v, rsv);
          }
        }
      }
    }
  if constexpr (EPI == EPI_KVPROJ && !NAT) {
    const int tok = t >> 1, half = t & 1, m = m0 + tok, b = m / TPB, pos = m - b * TPB, hh0 = n0 >> 6;
    const float* kr = reinterpret_cast<const float*>(P.ws + WS_KR) + (size_t)m * 32 + half * 16;
    float v[16];
#pragma unroll
    for (int q = 0; q < 4; ++q) { const float4 a = *reinterpret_cast<const float4*>(kr + q * 4); v[q * 4] = a.x; v[q * 4 + 1] = a.y; v[q * 4 + 2] = a.z; v[q * 4 + 3] = a.w; }
    if (pos < SEQ) {
      const float* R = reinterpret_cast<const float*>(P.ws + WS_ROPE);
#pragma unroll
      for (int pp = 0; pp < 8; ++pp) {
        const float c = R[pos * 16 + half * 8 + pp], s = R[2048 * 16 + pos * 16 + half * 8 + pp];
        const float a0 = v[2 * pp] * c - v[2 * pp + 1] * s, a1 = v[2 * pp] * s + v[2 * pp + 1] * c;
        v[2 * pp] = a0; v[2 * pp + 1] = a1;
      }
    }
    uint4 w0, w1;
    w0.x = pack2(v[0], v[1]); w0.y = pack2(v[2], v[3]); w0.z = pack2(v[4], v[5]); w0.w = pack2(v[6], v[7]);
    w1.x = pack2(v[8], v[9]); w1.y = pack2(v[10], v[11]); w1.z = pack2(v[12], v[13]); w1.w = pack2(v[14], v[15]);
#pragma unroll
    for (int q = 0; q < 2; ++q) {
      u16* dst = reinterpret_cast<u16*>(P.ws + WS_KMLA) + (((size_t)b * 8 + hh0 + q) * TPB + pos) * 96 + 64 + half * 16;
      *reinterpret_cast<uint4*>(dst) = w0;
      *reinterpret_cast<uint4*>(dst + 8) = w1;
    }
  }
}

constexpr int MTILES = MT / 128;

DI void phase_inproj(const Params& P, int layer, char* lds, int bid, int nblk) {
  const u16* A = reinterpret_cast<const u16*>(P.ws + WS_H);
  const u16* Bt = reinterpret_cast<const u16*>(P.ws + WS_WIN) + (size_t)layer * NPAD * 1024;
  for (int id = bid; id < MTILES * 24; id += nblk) {
    const int mt = id / 24, nt = id % 24;
    if (nt >= 8 && nt < 12) gemm_tile<EPI_INPROJ, false, true>(P, layer, lds, A, 1024, Bt, 1024, 1024, mt * 128, nt * 128);
    else gemm_tile<EPI_INPROJ, false, false>(P, layer, lds, A, 1024, Bt, 1024, 1024, mt * 128, nt * 128);
  }
}
DI void phase_subproj(const Params& P, int layer, char* lds, int bid, int nblk) {
  const u16* Aq = reinterpret_cast<const u16*>(P.ws + WS_CQ);
  const u16* Akv = reinterpret_cast<const u16*>(P.ws + WS_CKV);
  const u16* Bq = reinterpret_cast<const u16*>(P.ws + WS_WUQ) + (size_t)layer * 768 * 256;
  const u16* Bkv = reinterpret_cast<const u16*>(P.ws + WS_WUKV) + (size_t)layer * 1024 * 128;
  for (int id = bid; id < MTILES * 14; id += nblk) {
    const int mt = id / 14, nt = id % 14;
    if (nt < 6) gemm_tile<EPI_QPROJ, true, false>(P, layer, lds, Aq, 256, Bq, 256, 256, mt * 128, nt * 128);
    else if (nt < 10) gemm_tile<EPI_KVPROJ, true, false>(P, layer, lds, Akv, 128, Bkv, 128, 128, mt * 128, (nt - 6) * 128);
    else gemm_tile<EPI_KVPROJ, true, true>(P, layer, lds, Akv, 128, Bkv, 128, 128, mt * 128, (nt - 6) * 128);
  }
}
DI void phase_outproj(const Params& P, int layer, char* lds, int bid, int nblk) {
  const u16* A = reinterpret_cast<const u16*>(P.ws + WS_H);
  const u16* Bt = reinterpret_cast<const u16*>(P.ws + WS_WOUT) + (size_t)layer * 1024 * 1024;
  for (int id = bid; id < MTILES * 8; id += nblk) {
    const int mt = id / 8, nt = id % 8;
    if (layer == 1 && (mt % 18) >= 16) continue;
    gemm_tile<EPI_OUTPROJ, false, false>(P, layer, lds, A, 1024, Bt, 1024, 1024, mt * 128, nt * 128);
  }
}

struct AttnState { f32x16 o0, o1; float m, l; };

DI void attn_init(AttnState& st) {
#pragma unroll
  for (int r = 0; r < 16; ++r) { st.o0[r] = 0.f; st.o1[r] = 0.f; }
  st.m = -1e30f; st.l = 0.f;
}
DI void attn_tile(AttnState& st, f32x16 s, const u16* __restrict__ vt0, const u16* __restrict__ vt1, int h) {
  float mx = s[0];
#pragma unroll
  for (int r = 1; r < 16; ++r) mx = fmaxf(mx, s[r]);
  mx = fmaxf(mx, __shfl_xor(mx, 32));
  const float mn = fmaxf(st.m, mx);
  const float alpha = __builtin_amdgcn_exp2f(st.m - mn);
  st.m = mn;
  float p[16]; float sum = 0.f;
#pragma unroll
  for (int r = 0; r < 16; ++r) { p[r] = __builtin_amdgcn_exp2f(s[r] - mn); sum += p[r]; }
  st.l = st.l * alpha + sum;
#pragma unroll
  for (int r = 0; r < 16; ++r) { st.o0[r] *= alpha; st.o1[r] *= alpha; }
#pragma unroll
  for (int s2 = 0; s2 < 2; ++s2) {
    uint4 pw;
    pw.x = pack2(p[8 * s2], p[8 * s2 + 1]); pw.y = pack2(p[8 * s2 + 2], p[8 * s2 + 3]);
    pw.z = pack2(p[8 * s2 + 4], p[8 * s2 + 5]); pw.w = pack2(p[8 * s2 + 6], p[8 * s2 + 7]);
    const bf16x8 pf = as_frag(pw);
    const bf16x8 v0 = as_frag(ldg16(vt0 + 16 * s2 + 8 * h));
    const bf16x8 v1 = as_frag(ldg16(vt1 + 16 * s2 + 8 * h));
    st.o0 = MFMA32(v0, pf, st.o0);
    st.o1 = MFMA32(v1, pf, st.o1);
  }
}
DI void attn_store(const AttnState& st, const u16* __restrict__ grow, u16* __restrict__ orow, int h) {
  const float lt = st.l + __shfl_xor(st.l, 32);
  const float inv = 1.f / lt;
#pragma unroll
  for (int dt = 0; dt < 2; ++dt)
#pragma unroll
    for (int g = 0; g < 4; ++g) {
      const int d = dt * 32 + 8 * g + 4 * h;
      const uint2 gg = *reinterpret_cast<const uint2*>(grow + d);
      const f32x16& o = dt == 0 ? st.o0 : st.o1;
      const float a0 = o[4 * g] * inv * bflo(gg.x), a1 = o[4 * g + 1] * inv * bfhi(gg.x), a2 = o[4 * g + 2] * inv * bflo(gg.y), a3 = o[4 * g + 3] * inv * bfhi(gg.y);
      *reinterpret_cast<uint2*>(orow + d) = make_uint2(pack2(a0, a1), pack2(a2, a3));
    }
}

template <int NKS>
DI void dense_attn_wave(const u16* __restrict__ q, const u16* __restrict__ kbase, int k_ld, const u16* __restrict__ vt, int nkeys,
                        const u16* __restrict__ grow, u16* __restrict__ orow) {
  const int lane = threadIdx.x & 63, l31 = lane & 31, h = lane >> 5;
  bf16x8 qf[NKS];
#pragma unroll
  for (int s = 0; s < NKS; ++s) qf[s] = as_frag(ldg16(q + 16 * s + 8 * h));
  AttnState st; attn_init(st);
  const u16* krow = kbase + (size_t)kappa(l31) * k_ld + 8 * h;
  const u16* vt0 = vt + (size_t)l31 * TPB;
  const u16* vt1 = vt + (size_t)(32 + l31) * TPB;
  for (int kb = 0; kb < nkeys; kb += 32) {
    f32x16 s;
#pragma unroll
    for (int r = 0; r < 16; ++r) s[r] = 0.f;
#pragma unroll
    for (int ks = 0; ks < NKS; ++ks) s = MFMA32(as_frag(ldg16(krow + (size_t)kb * k_ld + 16 * ks)), qf[ks], s);
    attn_tile(st, s, vt0 + kb, vt1 + kb, h);
  }
  attn_store(st, grow, orow, h);
}

DI void na_wave(const Params& P, const float* bias, int b, int hh, int rp, int j) {
  const int lane = threadIdx.x & 63, l31 = lane & 31, h = lane >> 5;
  const int qrow = 2 * rp + (l31 >> 4), qcol = 16 * j + (l31 & 15);
  const int pos = qrow * 64 + qcol;
  const size_t T = (size_t)b * TPB + pos;
  const u16* QNA = reinterpret_cast<const u16*>(P.ws + WS_QNA);
  const u16* KNA = reinterpret_cast<const u16*>(P.ws + WS_KNA) + (size_t)b * TPB * 512 + hh * 64;
  const u16* VT = reinterpret_cast<const u16*>(P.ws + WS_VTNA) + ((size_t)b * 8 + hh) * 64 * TPB;
  bf16x8 qf[4];
#pragma unroll
  for (int s = 0; s < 4; ++s) qf[s] = as_frag(ldg16(QNA + T * 512 + hh * 64 + 16 * s + 8 * h));
  const int rs_q = min(max(qrow - 4, 0), 24), qcs = min(max(qcol - 8, 0), 48);
  const int rsA = min(max(2 * rp - 4, 0), 24), rsB = min(max(2 * rp - 3, 0), 24);
  const int nrows = 8 + rsB - rsA;
  const int cb = (j == 0) ? 0 : (j == 1 ? 8 : (j == 2 ? 24 : 32));
  AttnState st; attn_init(st);
  const u16* vt0 = VT + (size_t)l31 * TPB;
  const u16* vt1 = VT + (size_t)(32 + l31) * TPB;
  const int kap = kappa(l31);
  for (int tb = SEQ; tb < TPB; tb += 32) {
    f32x16 s;
#pragma unroll
    for (int r = 0; r < 16; ++r) s[r] = 0.f;
    const u16* krow = KNA + (size_t)(tb + kap) * 512 + 8 * h;
#pragma unroll
    for (int ks = 0; ks < 4; ++ks) s = MFMA32(as_frag(ldg16(krow + 16 * ks)), qf[ks], s);
    attn_tile(st, s, vt0 + tb, vt1 + tb, h);
  }
  for (int w = 0; w < nrows; ++w) {
    const int kr = rsA + w, tb = kr * 64 + cb;
    f32x16 s;
#pragma unroll
    for (int r = 0; r < 16; ++r) s[r] = 0.f;
    const u16* krow = KNA + (size_t)(tb + kap) * 512 + 8 * h;
#pragma unroll
    for (int ks = 0; ks < 4; ++ks) s = MFMA32(as_frag(ldg16(krow + 16 * ks)), qf[ks], s);
    const bool row_ok = (kr >= rs_q) && (kr < rs_q + 8);
    const int bbase = (kr - qrow + 7) * 31 + (cb - qcol + 15);
#pragma unroll
    for (int r = 0; r < 16; ++r) {
      const int ko = (r & 7) + 8 * h + 16 * (r >> 3);
      const int kc = cb + ko;
      const bool ok = row_ok && (kc >= qcs) && (kc < qcs + 16);
      const float bv = bias[ok ? (bbase + ko) : 0];
      s[r] = ok ? (s[r] + bv) : -1e30f;
    }
    attn_tile(st, s, vt0 + tb, vt1 + tb, h);
  }
  attn_store(st, reinterpret_cast<const u16*>(P.ws + WS_GNA) + T * 512 + hh * 64, reinterpret_cast<u16*>(P.ws + WS_H) + T * 1024 + hh * 64, h);
}

constexpr int N_MLA_U = NB * 8 * 16;
constexpr int N_NA_U = NB * 8 * 16;
constexpr int N_CTX_U = NB * 8 * 2;

DI void phase_attn(const Params& P, int layer, char* lds, int bid, int nblk) {
  const int t = threadIdx.x, lane = t & 63, wave = __builtin_amdgcn_readfirstlane(t >> 6), l31 = lane & 31;
  float* bias = reinterpret_cast<float*>(lds);
  const int total = N_MLA_U + N_NA_U + (layer == 0 ? 2 * N_CTX_U : 0);
  const u16* QM = reinterpret_cast<const u16*>(P.ws + WS_QMLA);
  const u16* KM = reinterpret_cast<const u16*>(P.ws + WS_KMLA);
  const u16* VM = reinterpret_cast<const u16*>(P.ws + WS_VTMLA);
  const u16* GM = reinterpret_cast<const u16*>(P.ws + WS_GMLA);
  u16* MIX = reinterpret_cast<u16*>(P.ws + WS_H);
  for (int u = bid; u < total; u += nblk) {
    if (u < N_MLA_U) {
      const int b = u >> 7, hh = (u >> 4) & 7, qb = u & 15;
      const size_t T = (size_t)b * TPB + qb * 128 + wave * 32 + l31;
      dense_attn_wave<6>(QM + T * 768 + hh * 96, KM + ((size_t)b * 8 + hh) * TPB * 96, 96, VM + ((size_t)b * 8 + hh) * 64 * TPB, TPB,
                         GM + T * 512 + hh * 64, MIX + T * 1024 + 512 + hh * 64);
    } else if (u < N_MLA_U + N_NA_U) {
      const int v = u - N_MLA_U, b = v >> 7, hh = (v >> 4) & 7, rp = v & 15;
      __syncthreads();
      for (int i = t; i < 15 * 31; i += NTHREADS) bias[i] = P.rpb[((size_t)layer * 8 + hh) * 465 + i] * LOG2E;
      __syncthreads();
      na_wave(P, bias, b, hh, rp, wave);
    } else {
      int v = u - N_MLA_U - N_NA_U;
      const bool is_na = v >= N_CTX_U; if (is_na) v -= N_CTX_U;
      const int b = v >> 4, hh = (v >> 1) & 7, qb = v & 1;
      const size_t T = (size_t)b * TPB + SEQ + qb * 128 + wave * 32 + l31;
      if (!is_na) {
        dense_attn_wave<6>(QM + T * 768 + hh * 96, KM + (((size_t)b * 8 + hh) * TPB + SEQ) * 96, 96, VM + ((size_t)b * 8 + hh) * 64 * TPB + SEQ, CTX,
                           GM + T * 512 + hh * 64, MIX + T * 1024 + 512 + hh * 64);
      } else {
        dense_attn_wave<4>(reinterpret_cast<const u16*>(P.ws + WS_QNA) + T * 512 + hh * 64,
                           reinterpret_cast<const u16*>(P.ws + WS_KNA) + ((size_t)b * TPB + SEQ) * 512 + hh * 64, 512,
                           reinterpret_cast<const u16*>(P.ws + WS_VTNA) + ((size_t)b * 8 + hh) * 64 * TPB + SEQ, CTX,
                           reinterpret_cast<const u16*>(P.ws + WS_GNA) + T * 512 + hh * 64, MIX + T * 1024 + hh * 64);
      }
    }
  }
}

DI void phase_final(const Params& P, int bid, int nblk) {
  const int t = threadIdx.x, lane = t & 63, wave = __builtin_amdgcn_readfirstlane(t >> 6);
  for (int row = bid * 4 + wave; row < NB * SEQ; row += nblk * 4) {
    float* src = P.out + (size_t)row * 1024;
    float4 v[4];
    float ss = 0.f;
#pragma unroll
    for (int q = 0; q < 4; ++q) { v[q] = *reinterpret_cast<const float4*>(src + q * 256 + lane * 4); ss += v[q].x * v[q].x + v[q].y * v[q].y + v[q].z * v[q].z + v[q].w * v[q].w; }
    ss = wave_sum(ss);
    const float rstd = rsqrtf(ss * (1.f / 1024.f) + EPS);
#pragma unroll
    for (int q = 0; q < 4; ++q) {
      const float4 g = *reinterpret_cast<const float4*>(P.final_g + q * 256 + lane * 4);
      *reinterpret_cast<float4*>(src + q * 256 + lane * 4) = make_float4(v[q].x * rstd * g.x, v[q].y * rstd * g.y, v[q].z * rstd * g.z, v[q].w * rstd * g.w);
    }
  }
}

DI void run_phase(const Params& P, int ph, char* lds, int bid, int nblk) {
#ifndef ONLY_K
#define ONLY_K -1
#endif
  if (ph == 0) { if (ONLY_K < 0 || ONLY_K == 5) phase0(P, lds, bid, nblk); return; }
  if (ph == 11) { if (ONLY_K < 0 || ONLY_K == 6) phase_final(P, bid, nblk); return; }
  const int layer = (ph - 1) / 5, k = (ph - 1) % 5;
  if (k == 0) { if (ONLY_K < 0 || ONLY_K == 0) phase_norm(P, layer, bid, nblk); }
  else if (k == 1) { if (ONLY_K < 0 || ONLY_K == 1) phase_inproj(P, layer, lds, bid, nblk); }
  else if (k == 2) { if (ONLY_K < 0 || ONLY_K == 2) phase_subproj(P, layer, lds, bid, nblk); }
  else if (k == 3) { if (ONLY_K < 0 || ONLY_K == 3) phase_attn(P, layer, lds, bid, nblk); }
  else { if (ONLY_K < 0 || ONLY_K == 4) phase_outproj(P, layer, lds, bid, nblk); }
}

__global__ void __launch_bounds__(NTHREADS, 2) k_phase(Params P, int ph) {
  extern __shared__ __attribute__((aligned(16))) char lds[];
  run_phase(P, ph, lds, blockIdx.x, gridDim.x);
}

#if MK_FUSED
__global__ void __launch_bounds__(NTHREADS, 2) k_mega(Params P) {
  extern __shared__ __attribute__((aligned(16))) char lds[];
  cg::grid_group grid = cg::this_grid();
#pragma unroll 1
  for (int ph = 0; ph < 12; ++ph) {
    run_phase(P, ph, lds, blockIdx.x, gridDim.x);
    if (ph < 11) grid.sync();
  }
}

#endif

extern "C" void kernel_launch(void* const* d_in, const int* in_sizes, int n_in, void* d_out, int out_size, void* d_ws, size_t ws_size, hipStream_t stream) {
  static int grid_blocks = 0;
  if (!grid_blocks) {
    int dev = 0, cus = 0, per_cu = 0;
    (void)hipGetDevice(&dev);
    (void)hipDeviceGetAttribute(&cus, hipDeviceAttributeMultiprocessorCount, dev);
#if MK_FUSED
    (void)hipFuncSetAttribute((const void*)k_mega, hipFuncAttributeMaxDynamicSharedMemorySize, LDS_BYTES);
#endif
    (void)hipFuncSetAttribute((const void*)k_phase, hipFuncAttributeMaxDynamicSharedMemorySize, LDS_BYTES);
#if MK_FUSED
    (void)hipOccupancyMaxActiveBlocksPerMultiprocessor(&per_cu, (const void*)k_mega, NTHREADS, LDS_BYTES);
#else
    (void)hipOccupancyMaxActiveBlocksPerMultiprocessor(&per_cu, (const void*)k_phase, NTHREADS, LDS_BYTES);
#endif
    if (per_cu > 2) per_cu = 2;
    if (per_cu < 1) per_cu = 1;
    grid_blocks = cus * per_cu;
  }
  Params p{};
  p.x = (const float*)d_in[0]; p.c = (const float*)d_in[1]; p.ctx = (const float*)d_in[2]; p.c_ctx = (const float*)d_in[3];
  p.norm_g = (const float*)d_in[4]; p.w_ada = (const float*)d_in[5]; p.b_ada = (const float*)d_in[6]; p.w_in = (const float*)d_in[7];
  p.rpb = (const float*)d_in[8]; p.q_norm_g = (const float*)d_in[9]; p.w_uq = (const float*)d_in[10]; p.kv_norm_g = (const float*)d_in[11];
  p.w_ukv = (const float*)d_in[12]; p.w_out = (const float*)d_in[13]; p.final_g = (const float*)d_in[14];
  p.out = (float*)d_out; p.ws = (unsigned char*)d_ws;
#if MK_FUSED
  void* args[] = {&p};
  hipError_t e = hipLaunchCooperativeKernel((const void*)k_mega, dim3(grid_blocks), dim3(NTHREADS), args, LDS_BYTES, stream);
  if (e != hipSuccess) fprintf(stderr, "cooperative launch failed: %s (grid %d)\n", hipGetErrorString(e), grid_blocks);
#else
  for (int ph = 0; ph < 12; ++ph) hipLaunchKernelGGL(k_phase, dim3(grid_blocks), dim3(NTHREADS), LDS_BYTES, stream, p, ph);
#endif
}
```

```cpp
#include <hip/hip_runtime.h>
#include <hip/hip_cooperative_groups.h>
#include <cstdio>
namespace cg = cooperative_groups;

#ifndef MK_FUSED
#define MK_FUSED 1
#endif

#define DI __device__ __forceinline__
typedef __attribute__((ext_vector_type(8))) short bf16x8;
typedef __attribute__((ext_vector_type(16))) float f32x16;
typedef __bf16 bf16_2 __attribute__((ext_vector_type(2)));
typedef float float_2 __attribute__((ext_vector_type(2)));
typedef unsigned short u16;
#define MFMA32(a, b, c) __builtin_amdgcn_mfma_f32_32x32x16_bf16((a), (b), (c), 0, 0, 0)

constexpr int NB = 32, SEQ = 2048, CTX = 256, TPB = SEQ + CTX;
constexpr int MT = NB * TPB;
constexpr int DM = 1024, DIN = 2976, NPAD = 3072;
constexpr float LOG2E = 1.4426950408889634f;
constexpr float NA_QS = 0.125f * LOG2E;
constexpr float MLA_QS = 0.10206207261596575f * LOG2E;
constexpr float EPS = 1e-6f;
constexpr int NTHREADS = 256;
constexpr int LDS_BYTES = 66560;

constexpr size_t al256(size_t x) { return (x + 255) & ~(size_t)255; }
constexpr size_t WS_CTL = 0;
constexpr size_t WS_MOD = 65536;
constexpr size_t WS_ROPE = WS_MOD + al256((size_t)2 * 33 * 3072 * 4);
constexpr size_t WS_WIN = WS_ROPE + (size_t)2 * 2048 * 16 * 4;
constexpr size_t WS_WUQ = WS_WIN + (size_t)2 * NPAD * 1024 * 2;
constexpr size_t WS_WUKV = WS_WUQ + (size_t)2 * 768 * 256 * 2;
constexpr size_t WS_WOUT = WS_WUKV + (size_t)2 * 1024 * 128 * 2;
constexpr size_t WS_H = WS_WOUT + (size_t)2 * 1024 * 1024 * 2;
constexpr size_t WS_QNA = WS_H + (size_t)MT * 1024 * 2;
constexpr size_t WS_KNA = WS_QNA + (size_t)MT * 512 * 2;
constexpr size_t WS_VTNA = WS_KNA + (size_t)MT * 512 * 2;
constexpr size_t WS_GNA = WS_VTNA + (size_t)MT * 512 * 2;
constexpr size_t WS_GMLA = WS_GNA + (size_t)MT * 512 * 2;
constexpr size_t WS_CQ = WS_GMLA + (size_t)MT * 512 * 2;
constexpr size_t WS_CKV = WS_CQ + (size_t)MT * 256 * 2;
constexpr size_t WS_KR = WS_CKV + (size_t)MT * 128 * 2;
constexpr size_t WS_QMLA = WS_KR + (size_t)MT * 32 * 4;
constexpr size_t WS_KMLA = WS_QMLA + (size_t)MT * 768 * 2;
constexpr size_t WS_VTMLA = WS_KMLA + (size_t)MT * 768 * 2;
constexpr size_t WS_CTX1 = WS_VTMLA + (size_t)MT * 512 * 2;
constexpr size_t WS_END = WS_CTX1 + (size_t)NB * CTX * 1024 * 4;
static_assert(WS_END <= (size_t)1073741824, "workspace");

struct Params {
  const float *x, *c, *ctx, *c_ctx, *norm_g, *w_ada, *b_ada, *w_in, *rpb, *q_norm_g, *w_uq, *kv_norm_g, *w_ukv, *w_out, *final_g;
  float* out;
  unsigned char* ws;
};

DI unsigned pack2(float a, float b) { float_2 f = {a, b}; bf16_2 r = __builtin_convertvector(f, bf16_2); return __builtin_bit_cast(unsigned, r); }
DI float bf2f(unsigned v) { return __uint_as_float(v << 16); }
DI float bflo(unsigned v) { return __uint_as_float(v << 16); }
DI float bfhi(unsigned v) { return __uint_as_float(v & 0xffff0000u); }
DI uint4 ldg16(const void* p) { return *reinterpret_cast<const uint4*>(p); }
DI bf16x8 as_frag(uint4 v) { return __builtin_bit_cast(bf16x8, v); }
DI float silu(float v) { return v / (1.f + __expf(-v)); }
DI int kappa(int i) { return (i & 0x13) | ((i & 4) << 1) | ((i & 8) >> 1); }
DI float wave_sum(float v) {
#pragma unroll
  for (int o = 32; o >= 1; o >>= 1) v += __shfl_xor(v, o);
  return v;
}

DI int remap_in(int n) { return n < 2432 ? n : (n < 2464 ? 2944 + (n - 2432) : 2432 + (n - 2464)); }
DI void transpose_item(int tid, const float* __restrict__ src, int K, int N, u16* __restrict__ dst, int k0, int n0, float* tile, int mode, const float* __restrict__ g) {
  const int t = tid;
  __syncthreads();
#pragma unroll 4
  for (int i = 0; i < 16; ++i) {
    const int kk = i * 4 + (t >> 6), nn = t & 63;
    float v = 0.f;
    if (n0 + nn < N) v = src[(size_t)(k0 + kk) * N + n0 + nn];
    if (mode == 2) v *= g[k0 + kk] * MLA_QS;
    if (mode == 3) v *= g[k0 + kk];
    if (mode == 0 && n0 + nn < 512) v *= NA_QS;
    tile[kk * 65 + nn] = v;
  }
  __syncthreads();
#pragma unroll 4
  for (int i = 0; i < 16; ++i) {
    const int nn = i * 4 + (t >> 6), kk = t & 63;
    const int n = n0 + nn;
    if (n < N) {
      const int nr = (mode == 0) ? remap_in(n) : (mode == 3 ? ((n & 64) ? 512 : 0) + (n >> 7) * 64 + (n & 63) : n);
      dst[(size_t)nr * K + k0 + kk] = (u16)(pack2(tile[kk * 65 + nn], 0.f) & 0xffffu);
    }
  }
}

DI void adaln_item(int tid, const Params& P, int l, int cc, float* sil) {
  const int t = tid, kg = t >> 5, cl = t & 31, n0 = cc * 32;
  float acc[33];
#pragma unroll
  for (int r = 0; r < 33; ++r) acc[r] = 0.f;
  const float* W = P.w_ada + (size_t)l * 1024 * 3072;
  for (int kq = 0; kq < 4; ++kq) {
    __syncthreads();
    for (int idx = t; idx < 33 * 256; idx += NTHREADS) {
      const int r = idx >> 8, kk = idx & 255;
      const float v = (r < 32) ? P.c[r * 1024 + kq * 256 + kk] : P.c_ctx[kq * 256 + kk];
      sil[idx] = silu(v);
    }
    __syncthreads();
    for (int kk = kg * 32; kk < kg * 32 + 32; ++kk) {
      const float w = W[(size_t)(kq * 256 + kk) * 3072 + n0 + cl];
#pragma unroll
      for (int r = 0; r < 33; ++r) acc[r] += sil[r * 256 + kk] * w;
    }
  }
  __syncthreads();
#pragma unroll
  for (int r = 0; r < 33; ++r) sil[(kg * 33 + r) * 32 + cl] = acc[r];
  __syncthreads();
  float* MOD = reinterpret_cast<float*>(P.ws + WS_MOD) + (size_t)l * 33 * 3072;
  for (int idx = t; idx < 33 * 32; idx += NTHREADS) {
    const int r = idx >> 5, c2 = idx & 31;
    float s = 0.f;
#pragma unroll
    for (int k2 = 0; k2 < 8; ++k2) s += sil[(k2 * 33 + r) * 32 + c2];
    MOD[r * 3072 + n0 + c2] = s + P.b_ada[l * 3072 + n0 + c2];
  }
}

constexpr int P0_ADA = 2 * 96, P0_TR_IN = 16 * 47, P0_TR_OUT = 256, P0_TR_UQ = 48, P0_TR_UKV = 32;
constexpr int P0_TR_L = P0_TR_IN + P0_TR_OUT + P0_TR_UQ + P0_TR_UKV;
constexpr int P0_PAD = 2, P0_ROPE = 128;
constexpr int P0_ITEMS = P0_ADA + 2 * P0_TR_L + P0_PAD + P0_ROPE;

DI void phase0(int tid, const Params& P, char* lds, int bid, int nblk) {
  float* fl = reinterpret_cast<float*>(lds);
  const int t = tid;
  for (int it = bid; it < P0_ITEMS; it += nblk) {
    int u = it;
    if (u < P0_ADA) { adaln_item(tid, P, u / 96, u % 96, fl); continue; }
    u -= P0_ADA;
    if (u < 2 * P0_TR_L) {
      const int l = u / P0_TR_L; int v = u % P0_TR_L;
      if (v < P0_TR_IN) {
        transpose_item(tid, P.w_in + (size_t)l * 1024 * DIN, 1024, DIN, reinterpret_cast<u16*>(P.ws + WS_WIN) + (size_t)l * NPAD * 1024, (v / 47) * 64, (v % 47) * 64, fl, 0, nullptr);
        continue;
      }
      v -= P0_TR_IN;
      if (v < P0_TR_OUT) {
        transpose_item(tid, P.w_out + (size_t)l * 1024 * 1024, 1024, 1024, reinterpret_cast<u16*>(P.ws + WS_WOUT) + (size_t)l * 1024 * 1024, (v / 16) * 64, (v % 16) * 64, fl, 1, nullptr);
        continue;
      }
      v -= P0_TR_OUT;
      if (v < P0_TR_UQ) {
        transpose_item(tid, P.w_uq + (size_t)l * 256 * 768, 256, 768, reinterpret_cast<u16*>(P.ws + WS_WUQ) + (size_t)l * 768 * 256, (v / 12) * 64, (v % 12) * 64, fl, 2, P.q_norm_g + l * 256);
        continue;
      }
      v -= P0_TR_UQ;
      transpose_item(tid, P.w_ukv + (size_t)l * 128 * 1024, 128, 1024, reinterpret_cast<u16*>(P.ws + WS_WUKV) + (size_t)l * 1024 * 128, (v / 16) * 64, (v % 16) * 64, fl, 3, P.kv_norm_g + l * 128);
      continue;
    }
    u -= 2 * P0_TR_L;
    if (u < P0_PAD) {
      uint4* d = reinterpret_cast<uint4*>(reinterpret_cast<u16*>(P.ws + WS_WIN) + ((size_t)u * NPAD + DIN) * 1024);
      for (int i = t; i < 96 * 1024 / 8; i += NTHREADS) d[i] = make_uint4(0, 0, 0, 0);
      continue;
    }
    u -= P0_PAD;
    {
      const int idx = u * 256 + t, pos = idx >> 4, p = idx & 15, row = pos >> 6, col = pos & 63, i = p & 7;
      const float inv = 1.0f / powf(10000.0f, (float)(2 * i) / 16.0f);
      const float ang = (float)(p < 8 ? row : col) * inv;
      float* R = reinterpret_cast<float*>(P.ws + WS_ROPE);
      R[idx] = cosf(ang);
      R[2048 * 16 + idx] = sinf(ang);
    }
  }
}

DI void phase_norm(int tid, const Params& P, int layer, int bid, int nblk) {
  const int t = tid, lane = t & 63, wave = __builtin_amdgcn_readfirstlane(t >> 6);
  const float* MOD = reinterpret_cast<const float*>(P.ws + WS_MOD) + (size_t)layer * 33 * 3072;
  const float* g = P.norm_g + layer * 1024;
  const float* xs = layer == 0 ? P.x : P.out;
  const float* cs = layer == 0 ? P.ctx : reinterpret_cast<const float*>(P.ws + WS_CTX1);
  u16* H = reinterpret_cast<u16*>(P.ws + WS_H);
  for (int row = bid * 4 + wave; row < MT; row += nblk * 4) {
    const int b = row / TPB, pos = row - b * TPB;
    const float* src = pos < SEQ ? xs + ((size_t)b * SEQ + pos) * 1024 : cs + ((size_t)b * CTX + (pos - SEQ)) * 1024;
    const float* md = MOD + (pos < SEQ ? b : 32) * 3072;
    float v[16];
#pragma unroll
    for (int q = 0; q < 2; ++q) {
      const float4 a = *reinterpret_cast<const float4*>(src + q * 512 + lane * 8);
      const float4 bq = *reinterpret_cast<const float4*>(src + q * 512 + lane * 8 + 4);
      v[q * 8 + 0] = a.x; v[q * 8 + 1] = a.y; v[q * 8 + 2] = a.z; v[q * 8 + 3] = a.w;
      v[q * 8 + 4] = bq.x; v[q * 8 + 5] = bq.y; v[q * 8 + 6] = bq.z; v[q * 8 + 7] = bq.w;
    }
    float ss = 0.f;
#pragma unroll
    for (int i = 0; i < 16; ++i) ss += v[i] * v[i];
    ss = wave_sum(ss);
    const float rstd = rsqrtf(ss * (1.f / 1024.f) + EPS);
#pragma unroll
    for (int q = 0; q < 2; ++q) {
      const int k = q * 512 + lane * 8;
      float o[8];
#pragma unroll
      for (int e = 0; e < 8; ++e) o[e] = v[q * 8 + e] * rstd * g[k + e] * (1.f + md[1024 + k + e]) + md[k + e];
      uint4 w;
      w.x = pack2(o[0], o[1]); w.y = pack2(o[2], o[3]); w.z = pack2(o[4], o[5]); w.w = pack2(o[6], o[7]);
      *reinterpret_cast<uint4*>(H + (size_t)row * 1024 + k) = w;
    }
  }
}

enum { EPI_INPROJ = 0, EPI_QPROJ = 1, EPI_KVPROJ = 2, EPI_OUTPROJ = 3 };

template <int EPI>
DI void epi_swapped(const Params& P, int layer, int m, int n, const float* v, float rs) {
  const int b = m / TPB, pos = m - b * TPB;
  if constexpr (EPI == EPI_INPROJ) {
    u16* dst; float o0 = v[0], o1 = v[1], o2 = v[2], o3 = v[3];
    if (n < 512) dst = reinterpret_cast<u16*>(P.ws + WS_QNA) + (size_t)m * 512 + n;
    else if (n < 1024) dst = reinterpret_cast<u16*>(P.ws + WS_KNA) + (size_t)m * 512 + (n - 512);
    else if (n < 2048) { dst = reinterpret_cast<u16*>(P.ws + WS_GNA) + (size_t)m * 512 + (n - 1536); o0 = silu(o0); o1 = silu(o1); o2 = silu(o2); o3 = silu(o3); }
    else if (n < 2304) dst = reinterpret_cast<u16*>(P.ws + WS_CQ) + (size_t)m * 256 + (n - 2048);
    else if (n < 2432) dst = reinterpret_cast<u16*>(P.ws + WS_CKV) + (size_t)m * 128 + (n - 2304);
    else if (n < 2944) { dst = reinterpret_cast<u16*>(P.ws + WS_GMLA) + (size_t)m * 512 + (n - 2432); o0 = silu(o0); o1 = silu(o1); o2 = silu(o2); o3 = silu(o3); }
    else if (n < 2976) { *reinterpret_cast<float4*>(reinterpret_cast<float*>(P.ws + WS_KR) + (size_t)m * 32 + (n - 2944)) = make_float4(o0, o1, o2, o3); return; }
    else return;
    *reinterpret_cast<uint2*>(dst) = make_uint2(pack2(o0, o1), pack2(o2, o3));
  } else if constexpr (EPI == EPI_QPROJ) {
    float o0 = v[0] * rs, o1 = v[1] * rs, o2 = v[2] * rs, o3 = v[3] * rs;
    const int dd = n % 96;
    if (dd >= 64 && pos < SEQ) {
      const float* R = reinterpret_cast<const float*>(P.ws + WS_ROPE);
      const int p0 = (dd - 64) >> 1;
      const float c0 = R[pos * 16 + p0], s0 = R[2048 * 16 + pos * 16 + p0], c1 = R[pos * 16 + p0 + 1], s1 = R[2048 * 16 + pos * 16 + p0 + 1];
      const float a0 = o0 * c0 - o1 * s0, a1 = o0 * s0 + o1 * c0, a2 = o2 * c1 - o3 * s1, a3 = o2 * s1 + o3 * c1;
      o0 = a0; o1 = a1; o2 = a2; o3 = a3;
    }
    *reinterpret_cast<uint2*>(reinterpret_cast<u16*>(P.ws + WS_QMLA) + (size_t)m * 768 + n) = make_uint2(pack2(o0, o1), pack2(o2, o3));
  } else if constexpr (EPI == EPI_KVPROJ) {
    const int hh = n >> 6, e = n & 63;
    u16* dst = reinterpret_cast<u16*>(P.ws + WS_KMLA) + (((size_t)b * 8 + hh) * TPB + pos) * 96 + e;
    *reinterpret_cast<uint2*>(dst) = make_uint2(pack2(v[0] * rs, v[1] * rs), pack2(v[2] * rs, v[3] * rs));
  } else {
    const float* MOD = reinterpret_cast<const float*>(P.ws + WS_MOD) + (size_t)layer * 33 * 3072;
    const float4 gt = *reinterpret_cast<const float4*>(MOD + (pos < SEQ ? b : 32) * 3072 + 2048 + n);
    const float* src; float* dst;
    if (pos < SEQ) { const size_t o = ((size_t)b * SEQ + pos) * 1024 + n; src = (layer == 0 ? P.x : P.out) + o; dst = P.out + o; }
    else { const size_t o = ((size_t)b * CTX + (pos - SEQ)) * 1024 + n; src = P.ctx + o; dst = reinterpret_cast<float*>(P.ws + WS_CTX1) + o; }
    const float4 xv = *reinterpret_cast<const float4*>(src);
    *reinterpret_cast<float4*>(dst) = make_float4(xv.x + gt.x * v[0], xv.y + gt.y * v[1], xv.z + gt.z * v[2], xv.w + gt.w * v[3]);
  }
}

template <int EPI>
DI void epi_natural(const Params& P, int m, int n, const float* v, const float* rsv) {
  const int b = m / TPB, pos = m - b * TPB;
  if constexpr (EPI == EPI_INPROJ) {
    const int vc = n - 1024, hh = vc >> 6, d = vc & 63;
    u16* dst = reinterpret_cast<u16*>(P.ws + WS_VTNA) + (((size_t)b * 8 + hh) * 64 + d) * TPB + pos;
    *reinterpret_cast<uint2*>(dst) = make_uint2(pack2(v[0], v[1]), pack2(v[2], v[3]));
  } else {
    const int hh = (n - 512) >> 6, d = n & 63;
    u16* dst = reinterpret_cast<u16*>(P.ws + WS_VTMLA) + (((size_t)b * 8 + hh) * 64 + d) * TPB + pos;
    *reinterpret_cast<uint2*>(dst) = make_uint2(pack2(v[0] * rsv[0], v[1] * rsv[1]), pack2(v[2] * rsv[2], v[3] * rsv[3]));
  }
}

template <int EPI, bool ROWNORM, bool NAT>
DI void gemm_tile(int tid, const Params& P, int layer, char* lds, const u16* __restrict__ A, int lda, const u16* __restrict__ Bt, int ldb, int K, int m0, int n0) {
  const int t = tid, lane = t & 63, wave = __builtin_amdgcn_readfirstlane(t >> 6), wm = wave >> 1, wn = wave & 1;
  const int l31 = lane & 31, h = lane >> 5;
  const int ld_row = t >> 3, ld_chk = t & 7;
  const unsigned st_off = ld_row * 128 + ((ld_chk ^ ((ld_row >> 1) & 7)) << 4);
  const int swz = (l31 >> 1) & 7;
  const unsigned a_off = (wm * 64 + l31) * 128, b_off = (wn * 64 + l31) * 128;
  float* rstd_s = reinterpret_cast<float*>(lds + 65536);


  const u16* gA = A + (size_t)(m0 + ld_row) * lda + ld_chk * 8;
  const u16* gB = Bt + (size_t)(n0 + ld_row) * ldb + ld_chk * 8;
  uint4 ra[4], rb[4];
  float ss[4] = {0.f, 0.f, 0.f, 0.f};
  f32x16 acc[2][2];
#pragma unroll
  for (int i = 0; i < 2; ++i)
#pragma unroll
    for (int j = 0; j < 2; ++j)
#pragma unroll
      for (int r = 0; r < 16; ++r) acc[i][j][r] = 0.f;

  const int KT = K / 64;
#pragma unroll
  for (int i = 0; i < 4; ++i) { ra[i] = ldg16(gA + (size_t)i * 32 * lda); rb[i] = ldg16(gB + (size_t)i * 32 * ldb); }
  for (int kt = 0; kt < KT; ++kt) {
    char* bufA = lds + (kt & 1) * 16384;
    char* bufB = lds + 32768 + (kt & 1) * 16384;
#pragma unroll
    for (int i = 0; i < 4; ++i) {
      *reinterpret_cast<uint4*>(bufA + st_off + i * 4096) = ra[i];
      *reinterpret_cast<uint4*>(bufB + st_off + i * 4096) = rb[i];
    }
    if constexpr (ROWNORM) {
#pragma unroll
      for (int i = 0; i < 4; ++i) {
        const unsigned w4[4] = {ra[i].x, ra[i].y, ra[i].z, ra[i].w};
#pragma unroll
        for (int e = 0; e < 4; ++e) { const float lo = bflo(w4[e]), hi = bfhi(w4[e]); ss[i] += lo * lo + hi * hi; }
      }
    }
    __syncthreads();
    if (kt + 1 < KT) {
#pragma unroll
      for (int i = 0; i < 4; ++i) { ra[i] = ldg16(gA + (size_t)i * 32 * lda + (kt + 1) * 64); rb[i] = ldg16(gB + (size_t)i * 32 * ldb + (kt + 1) * 64); }
    }
#pragma unroll
    for (int ks = 0; ks < 4; ++ks) {
      const unsigned co = ((ks * 2 + h) ^ swz) << 4;
      bf16x8 af[2], bfr[2];
#pragma unroll
      for (int i = 0; i < 2; ++i) {
        af[i] = as_frag(*reinterpret_cast<const uint4*>(bufA + a_off + i * 4096 + co));
        bfr[i] = as_frag(*reinterpret_cast<const uint4*>(bufB + b_off + i * 4096 + co));
      }
      if constexpr (NAT) {
#pragma unroll
        for (int i = 0; i < 2; ++i)
#pragma unroll
          for (int j = 0; j < 2; ++j) acc[i][j] = MFMA32(af[i], bfr[j], acc[i][j]);
      } else {
#pragma unroll
        for (int i = 0; i < 2; ++i)
#pragma unroll
          for (int j = 0; j < 2; ++j) acc[i][j] = MFMA32(bfr[j], af[i], acc[i][j]);
      }
    }
  }
  if constexpr (ROWNORM) {
#pragma unroll
    for (int i = 0; i < 4; ++i) {
      float s = ss[i];
      s += __shfl_xor(s, 1); s += __shfl_xor(s, 2); s += __shfl_xor(s, 4);
      if (ld_chk == 0) rstd_s[ld_row + 32 * i] = rsqrtf(s / (float)K + EPS);
    }
  }
  __syncthreads();

#pragma unroll
  for (int i = 0; i < 2; ++i)
#pragma unroll
    for (int j = 0; j < 2; ++j) {
      if constexpr (!NAT) {
        const int ml = wm * 64 + i * 32 + l31;
        float rs = 1.f;
        if constexpr (ROWNORM) rs = rstd_s[ml];
#pragma unroll
        for (int g = 0; g < 4; ++g) {
          const float v[4] = {acc[i][j][4 * g], acc[i][j][4 * g + 1], acc[i][j][4 * g + 2], acc[i][j][4 * g + 3]};
          epi_swapped<EPI>(P, layer, m0 + ml, n0 + wn * 64 + j * 32 + 8 * g + 4 * h, v, rs);
        }
      } else {
        if constexpr (EPI == EPI_INPROJ || EPI == EPI_KVPROJ) {
#pragma unroll
          for (int g = 0; g < 4; ++g) {
            const int ml = wm * 64 + i * 32 + 8 * g + 4 * h;
            const float v[4] = {acc[i][j][4 * g], acc[i][j][4 * g + 1], acc[i][j][4 * g + 2], acc[i][j][4 * g + 3]};
            float rsv[4] = {1.f, 1.f, 1.f, 1.f};
            if constexpr (ROWNORM) { rsv[0] = rstd_s[ml]; rsv[1] = rstd_s[ml + 1]; rsv[2] = rstd_s[ml + 2]; rsv[3] = rstd_s[ml + 3]; }
            epi_natural<EPI>(P, m0 + ml, n0 + wn * 64 + j * 32 + l31, v, rsv);
          }
        }
      }
    }
  if constexpr (EPI == EPI_KVPROJ && !NAT) {
    const int tok = t >> 1, half = t & 1, m = m0 + tok, b = m / TPB, pos = m - b * TPB, hh0 = n0 >> 6;
    const float* kr = reinterpret_cast<const float*>(P.ws + WS_KR) + (size_t)m * 32 + half * 16;
    float v[16];
#pragma unroll
    for (int q = 0; q < 4; ++q) { const float4 a = *reinterpret_cast<const float4*>(kr + q * 4); v[q * 4] = a.x; v[q * 4 + 1] = a.y; v[q * 4 + 2] = a.z; v[q * 4 + 3] = a.w; }
    if (pos < SEQ) {
      const float* R = reinterpret_cast<const float*>(P.ws + WS_ROPE);
#pragma unroll
      for (int pp = 0; pp < 8; ++pp) {
        const float c = R[pos * 16 + half * 8 + pp], s = R[2048 * 16 + pos * 16 + half * 8 + pp];
        const float a0 = v[2 * pp] * c - v[2 * pp + 1] * s, a1 = v[2 * pp] * s + v[2 * pp + 1] * c;
        v[2 * pp] = a0; v[2 * pp + 1] = a1;
      }
    }
    uint4 w0, w1;
    w0.x = pack2(v[0], v[1]); w0.y = pack2(v[2], v[3]); w0.z = pack2(v[4], v[5]); w0.w = pack2(v[6], v[7]);
    w1.x = pack2(v[8], v[9]); w1.y = pack2(v[10], v[11]); w1.z = pack2(v[12], v[13]); w1.w = pack2(v[14], v[15]);
#pragma unroll
    for (int q = 0; q < 2; ++q) {
      u16* dst = reinterpret_cast<u16*>(P.ws + WS_KMLA) + (((size_t)b * 8 + hh0 + q) * TPB + pos) * 96 + 64 + half * 16;
      *reinterpret_cast<uint4*>(dst) = w0;
      *reinterpret_cast<uint4*>(dst + 8) = w1;
    }
  }
}

constexpr int MTILES = MT / 128;

DI void phase_inproj(int tid, const Params& P, int layer, char* lds, int bid, int nblk) {
  const u16* A = reinterpret_cast<const u16*>(P.ws + WS_H);
  const u16* Bt = reinterpret_cast<const u16*>(P.ws + WS_WIN) + (size_t)layer * NPAD * 1024;
  for (int id = bid; id < MTILES * 24; id += nblk) {
    const int mt = id / 24, nt = id % 24;
    if (nt >= 8 && nt < 12) gemm_tile<EPI_INPROJ, false, true>(tid, P, layer, lds, A, 1024, Bt, 1024, 1024, mt * 128, nt * 128);
    else gemm_tile<EPI_INPROJ, false, false>(tid, P, layer, lds, A, 1024, Bt, 1024, 1024, mt * 128, nt * 128);
  }
}
DI void phase_subproj(int tid, const Params& P, int layer, char* lds, int bid, int nblk) {
  const u16* Aq = reinterpret_cast<const u16*>(P.ws + WS_CQ);
  const u16* Akv = reinterpret_cast<const u16*>(P.ws + WS_CKV);
  const u16* Bq = reinterpret_cast<const u16*>(P.ws + WS_WUQ) + (size_t)layer * 768 * 256;
  const u16* Bkv = reinterpret_cast<const u16*>(P.ws + WS_WUKV) + (size_t)layer * 1024 * 128;
  for (int id = bid; id < MTILES * 14; id += nblk) {
    const int mt = id / 14, nt = id % 14;
    if (nt < 6) gemm_tile<EPI_QPROJ, true, false>(tid, P, layer, lds, Aq, 256, Bq, 256, 256, mt * 128, nt * 128);
    else if (nt < 10) gemm_tile<EPI_KVPROJ, true, false>(tid, P, layer, lds, Akv, 128, Bkv, 128, 128, mt * 128, (nt - 6) * 128);
    else gemm_tile<EPI_KVPROJ, true, true>(tid, P, layer, lds, Akv, 128, Bkv, 128, 128, mt * 128, (nt - 6) * 128);
  }
}
DI void phase_outproj(int tid, const Params& P, int layer, char* lds, int bid, int nblk) {
  const u16* A = reinterpret_cast<const u16*>(P.ws + WS_H);
  const u16* Bt = reinterpret_cast<const u16*>(P.ws + WS_WOUT) + (size_t)layer * 1024 * 1024;
  for (int id = bid; id < MTILES * 8; id += nblk) {
    const int mt = id / 8, nt = id % 8;
    if (layer == 1 && (mt % 18) >= 16) continue;
    gemm_tile<EPI_OUTPROJ, false, false>(tid, P, layer, lds, A, 1024, Bt, 1024, 1024, mt * 128, nt * 128);
  }
}

struct AttnState { f32x16 o0, o1; float m, l; };

DI void attn_init(AttnState& st) {
#pragma unroll
  for (int r = 0; r < 16; ++r) { st.o0[r] = 0.f; st.o1[r] = 0.f; }
  st.m = -1e30f; st.l = 0.f;
}
DI void attn_tile(AttnState& st, f32x16 s, const u16* __restrict__ vt0, const u16* __restrict__ vt1, int h) {
  float mx = s[0];
#pragma unroll
  for (int r = 1; r < 16; ++r) mx = fmaxf(mx, s[r]);
  mx = fmaxf(mx, __shfl_xor(mx, 32));
  const float mn = fmaxf(st.m, mx);
  const float alpha = __builtin_amdgcn_exp2f(st.m - mn);
  st.m = mn;
  float p[16]; float sum = 0.f;
#pragma unroll
  for (int r = 0; r < 16; ++r) { p[r] = __builtin_amdgcn_exp2f(s[r] - mn); sum += p[r]; }
  st.l = st.l * alpha + sum;
#pragma unroll
  for (int r = 0; r < 16; ++r) { st.o0[r] *= alpha; st.o1[r] *= alpha; }
#pragma unroll
  for (int s2 = 0; s2 < 2; ++s2) {
    uint4 pw;
    pw.x = pack2(p[8 * s2], p[8 * s2 + 1]); pw.y = pack2(p[8 * s2 + 2], p[8 * s2 + 3]);
    pw.z = pack2(p[8 * s2 + 4], p[8 * s2 + 5]); pw.w = pack2(p[8 * s2 + 6], p[8 * s2 + 7]);
    const bf16x8 pf = as_frag(pw);
    const bf16x8 v0 = as_frag(ldg16(vt0 + 16 * s2 + 8 * h));
    const bf16x8 v1 = as_frag(ldg16(vt1 + 16 * s2 + 8 * h));
    st.o0 = MFMA32(v0, pf, st.o0);
    st.o1 = MFMA32(v1, pf, st.o1);
  }
}
DI void attn_store(const AttnState& st, const u16* __restrict__ grow, u16* __restrict__ orow, int h) {
  const float lt = st.l + __shfl_xor(st.l, 32);
  const float inv = 1.f / lt;
#pragma unroll
  for (int dt = 0; dt < 2; ++dt)
#pragma unroll
    for (int g = 0; g < 4; ++g) {
      const int d = dt * 32 + 8 * g + 4 * h;
      const uint2 gg = *reinterpret_cast<const uint2*>(grow + d);
      const f32x16& o = dt == 0 ? st.o0 : st.o1;
      const float a0 = o[4 * g] * inv * bflo(gg.x), a1 = o[4 * g + 1] * inv * bfhi(gg.x), a2 = o[4 * g + 2] * inv * bflo(gg.y), a3 = o[4 * g + 3] * inv * bfhi(gg.y);
      *reinterpret_cast<uint2*>(orow + d) = make_uint2(pack2(a0, a1), pack2(a2, a3));
    }
}

template <int NKS>
DI void dense_attn_wave(int tid, const u16* __restrict__ q, const u16* __restrict__ kbase, int k_ld, const u16* __restrict__ vt, int nkeys,
                        const u16* __restrict__ grow, u16* __restrict__ orow) {
  const int lane = tid & 63, l31 = lane & 31, h = lane >> 5;
  bf16x8 qf[NKS];
#pragma unroll
  for (int s = 0; s < NKS; ++s) qf[s] = as_frag(ldg16(q + 16 * s + 8 * h));
  AttnState st; attn_init(st);
  const u16* krow = kbase + (size_t)kappa(l31) * k_ld + 8 * h;
  const u16* vt0 = vt + (size_t)l31 * TPB;
  const u16* vt1 = vt + (size_t)(32 + l31) * TPB;
  for (int kb = 0; kb < nkeys; kb += 32) {
    f32x16 s;
#pragma unroll
    for (int r = 0; r < 16; ++r) s[r] = 0.f;
#pragma unroll
    for (int ks = 0; ks < NKS; ++ks) s = MFMA32(as_frag(ldg16(krow + (size_t)kb * k_ld + 16 * ks)), qf[ks], s);
    attn_tile(st, s, vt0 + kb, vt1 + kb, h);
  }
  attn_store(st, grow, orow, h);
}

DI void na_wave(int tid, const Params& P, const float* bias, int b, int hh, int rp, int j) {
  const int lane = tid & 63, l31 = lane & 31, h = lane >> 5;
  const int qrow = 2 * rp + (l31 >> 4), qcol = 16 * j + (l31 & 15);
  const int pos = qrow * 64 + qcol;
  const size_t T = (size_t)b * TPB + pos;
  const u16* QNA = reinterpret_cast<const u16*>(P.ws + WS_QNA);
  const u16* KNA = reinterpret_cast<const u16*>(P.ws + WS_KNA) + (size_t)b * TPB * 512 + hh * 64;
  const u16* VT = reinterpret_cast<const u16*>(P.ws + WS_VTNA) + ((size_t)b * 8 + hh) * 64 * TPB;
  bf16x8 qf[4];
#pragma unroll
  for (int s = 0; s < 4; ++s) qf[s] = as_frag(ldg16(QNA + T * 512 + hh * 64 + 16 * s + 8 * h));
  const int rs_q = min(max(qrow - 4, 0), 24), qcs = min(max(qcol - 8, 0), 48);
  const int rsA = min(max(2 * rp - 4, 0), 24), rsB = min(max(2 * rp - 3, 0), 24);
  const int nrows = 8 + rsB - rsA;
  const int cb = (j == 0) ? 0 : (j == 1 ? 8 : (j == 2 ? 24 : 32));
  AttnState st; attn_init(st);
  const u16* vt0 = VT + (size_t)l31 * TPB;
  const u16* vt1 = VT + (size_t)(32 + l31) * TPB;
  const int kap = kappa(l31);
  for (int tb = SEQ; tb < TPB; tb += 32) {
    f32x16 s;
#pragma unroll
    for (int r = 0; r < 16; ++r) s[r] = 0.f;
    const u16* krow = KNA + (size_t)(tb + kap) * 512 + 8 * h;
#pragma unroll
    for (int ks = 0; ks < 4; ++ks) s = MFMA32(as_frag(ldg16(krow + 16 * ks)), qf[ks], s);
    attn_tile(st, s, vt0 + tb, vt1 + tb, h);
  }
  for (int w = 0; w < nrows; ++w) {
    const int kr = rsA + w, tb = kr * 64 + cb;
    f32x16 s;
#pragma unroll
    for (int r = 0; r < 16; ++r) s[r] = 0.f;
    const u16* krow = KNA + (size_t)(tb + kap) * 512 + 8 * h;
#pragma unroll
    for (int ks = 0; ks < 4; ++ks) s = MFMA32(as_frag(ldg16(krow + 16 * ks)), qf[ks], s);
    const bool row_ok = (kr >= rs_q) && (kr < rs_q + 8);
    const int bbase = (kr - qrow + 7) * 31 + (cb - qcol + 15);
#pragma unroll
    for (int r = 0; r < 16; ++r) {
      const int ko = (r & 7) + 8 * h + 16 * (r >> 3);
      const int kc = cb + ko;
      const bool ok = row_ok && (kc >= qcs) && (kc < qcs + 16);
      const float bv = bias[ok ? (bbase + ko) : 0];
      s[r] = ok ? (s[r] + bv) : -1e30f;
    }
    attn_tile(st, s, vt0 + tb, vt1 + tb, h);
  }
  attn_store(st, reinterpret_cast<const u16*>(P.ws + WS_GNA) + T * 512 + hh * 64, reinterpret_cast<u16*>(P.ws + WS_H) + T * 1024 + hh * 64, h);
}

constexpr int N_MLA_U = NB * 8 * 16;
constexpr int N_NA_U = NB * 8 * 16;
constexpr int N_CTX_U = NB * 8 * 2;

DI void phase_attn(int tid, const Params& P, int layer, char* lds, int bid, int nblk) {
  const int t = tid, lane = t & 63, wave = __builtin_amdgcn_readfirstlane(t >> 6), l31 = lane & 31;
  float* bias = reinterpret_cast<float*>(lds);
  const int total = N_MLA_U + N_NA_U + (layer == 0 ? 2 * N_CTX_U : 0);
  const u16* QM = reinterpret_cast<const u16*>(P.ws + WS_QMLA);
  const u16* KM = reinterpret_cast<const u16*>(P.ws + WS_KMLA);
  const u16* VM = reinterpret_cast<const u16*>(P.ws + WS_VTMLA);
  const u16* GM = reinterpret_cast<const u16*>(P.ws + WS_GMLA);
  u16* MIX = reinterpret_cast<u16*>(P.ws + WS_H);
  for (int u = bid; u < total; u += nblk) {
    if (u < N_MLA_U) {
      const int b = u >> 7, hh = (u >> 4) & 7, qb = u & 15;
      const size_t T = (size_t)b * TPB + qb * 128 + wave * 32 + l31;
      dense_attn_wave<6>(tid, QM + T * 768 + hh * 96, KM + ((size_t)b * 8 + hh) * TPB * 96, 96, VM + ((size_t)b * 8 + hh) * 64 * TPB, TPB,
                         GM + T * 512 + hh * 64, MIX + T * 1024 + 512 + hh * 64);
    } else if (u < N_MLA_U + N_NA_U) {
      const int v = u - N_MLA_U, b = v >> 7, hh = (v >> 4) & 7, rp = v & 15;
      __syncthreads();
      for (int i = t; i < 15 * 31; i += NTHREADS) bias[i] = P.rpb[((size_t)layer * 8 + hh) * 465 + i] * LOG2E;
      __syncthreads();
      na_wave(tid, P, bias, b, hh, rp, wave);
    } else {
      int v = u - N_MLA_U - N_NA_U;
      const bool is_na = v >= N_CTX_U; if (is_na) v -= N_CTX_U;
      const int b = v >> 4, hh = (v >> 1) & 7, qb = v & 1;
      const size_t T = (size_t)b * TPB + SEQ + qb * 128 + wave * 32 + l31;
      if (!is_na) {
        dense_attn_wave<6>(tid, QM + T * 768 + hh * 96, KM + (((size_t)b * 8 + hh) * TPB + SEQ) * 96, 96, VM + ((size_t)b * 8 + hh) * 64 * TPB + SEQ, CTX,
                           GM + T * 512 + hh * 64, MIX + T * 1024 + 512 + hh * 64);
      } else {
        dense_attn_wave<4>(tid, reinterpret_cast<const u16*>(P.ws + WS_QNA) + T * 512 + hh * 64,
                           reinterpret_cast<const u16*>(P.ws + WS_KNA) + ((size_t)b * TPB + SEQ) * 512 + hh * 64, 512,
                           reinterpret_cast<const u16*>(P.ws + WS_VTNA) + ((size_t)b * 8 + hh) * 64 * TPB + SEQ, CTX,
                           reinterpret_cast<const u16*>(P.ws + WS_GNA) + T * 512 + hh * 64, MIX + T * 1024 + hh * 64);
      }
    }
  }
}

DI void phase_final(int tid, const Params& P, int bid, int nblk) {
  const int t = tid, lane = t & 63, wave = __builtin_amdgcn_readfirstlane(t >> 6);
  for (int row = bid * 4 + wave; row < NB * SEQ; row += nblk * 4) {
    float* src = P.out + (size_t)row * 1024;
    float4 v[4];
    float ss = 0.f;
#pragma unroll
    for (int q = 0; q < 4; ++q) { v[q] = *reinterpret_cast<const float4*>(src + q * 256 + lane * 4); ss += v[q].x * v[q].x + v[q].y * v[q].y + v[q].z * v[q].z + v[q].w * v[q].w; }
    ss = wave_sum(ss);
    const float rstd = rsqrtf(ss * (1.f / 1024.f) + EPS);
#pragma unroll
    for (int q = 0; q < 4; ++q) {
      const float4 g = *reinterpret_cast<const float4*>(P.final_g + q * 256 + lane * 4);
      *reinterpret_cast<float4*>(src + q * 256 + lane * 4) = make_float4(v[q].x * rstd * g.x, v[q].y * rstd * g.y, v[q].z * rstd * g.z, v[q].w * rstd * g.w);
    }
  }
}

DI void run_phase(int tid, const Params& P, int ph, char* lds, int bid, int nblk) {
#ifndef ONLY_K
#define ONLY_K -1
#endif
  if (ph == 0) { if (ONLY_K < 0 || ONLY_K == 5) phase0(tid, P, lds, bid, nblk); return; }
  if (ph == 11) { if (ONLY_K < 0 || ONLY_K == 6) phase_final(tid, P, bid, nblk); return; }
  const int layer = (ph - 1) / 5, k = (ph - 1) % 5;
  if (k == 0) { if (ONLY_K < 0 || ONLY_K == 0) phase_norm(tid, P, layer, bid, nblk); }
  else if (k == 1) { if (ONLY_K < 0 || ONLY_K == 1) phase_inproj(tid, P, layer, lds, bid, nblk); }
  else if (k == 2) { if (ONLY_K < 0 || ONLY_K == 2) phase_subproj(tid, P, layer, lds, bid, nblk); }
  else if (k == 3) { if (ONLY_K < 0 || ONLY_K == 3) phase_attn(tid, P, layer, lds, bid, nblk); }
  else { if (ONLY_K < 0 || ONLY_K == 4) phase_outproj(tid, P, layer, lds, bid, nblk); }
}

__global__ void __launch_bounds__(NTHREADS, 2) k_phase(Params P, int ph) {
  extern __shared__ __attribute__((aligned(16))) char lds[];
  const int tid = threadIdx.x;
  run_phase(tid, P, ph, lds, blockIdx.x, gridDim.x);
}

#if MK_FUSED
__global__ void __launch_bounds__(NTHREADS, 2) k_mega(Params P) {
  extern __shared__ __attribute__((aligned(16))) char lds[];
  cg::grid_group grid = cg::this_grid();
#pragma unroll 1
  for (int ph = 0; ph < 12; ++ph) {
    int tid = threadIdx.x;
    asm volatile("" : "+v"(tid));
    run_phase(tid, P, ph, lds, blockIdx.x, gridDim.x);
    if (ph < 11) grid.sync();
  }
}

#endif

extern "C" void kernel_launch(void* const* d_in, const int* in_sizes, int n_in, void* d_out, int out_size, void* d_ws, size_t ws_size, hipStream_t stream) {
  static int grid_blocks = 0;
  if (!grid_blocks) {
    int dev = 0, cus = 0, per_cu = 0;
    (void)hipGetDevice(&dev);
    (void)hipDeviceGetAttribute(&cus, hipDeviceAttributeMultiprocessorCount, dev);
#if MK_FUSED
    (void)hipFuncSetAttribute((const void*)k_mega, hipFuncAttributeMaxDynamicSharedMemorySize, LDS_BYTES);
#endif
    (void)hipFuncSetAttribute((const void*)k_phase, hipFuncAttributeMaxDynamicSharedMemorySize, LDS_BYTES);
#if MK_FUSED
    (void)hipOccupancyMaxActiveBlocksPerMultiprocessor(&per_cu, (const void*)k_mega, NTHREADS, LDS_BYTES);
#else
    (void)hipOccupancyMaxActiveBlocksPerMultiprocessor(&per_cu, (const void*)k_phase, NTHREADS, LDS_BYTES);
#endif
    if (per_cu > 2) per_cu = 2;
    if (per_cu < 1) per_cu = 1;
    grid_blocks = cus * per_cu;
  }
  Params p{};
  p.x = (const float*)d_in[0]; p.c = (const float*)d_in[1]; p.ctx = (const float*)d_in[2]; p.c_ctx = (const float*)d_in[3];
  p.norm_g = (const float*)d_in[4]; p.w_ada = (const float*)d_in[5]; p.b_ada = (const float*)d_in[6]; p.w_in = (const float*)d_in[7];
  p.rpb = (const float*)d_in[8]; p.q_norm_g = (const float*)d_in[9]; p.w_uq = (const float*)d_in[10]; p.kv_norm_g = (const float*)d_in[11];
  p.w_ukv = (const float*)d_in[12]; p.w_out = (const float*)d_in[13]; p.final_g = (const float*)d_in[14];
  p.out = (float*)d_out; p.ws = (unsigned char*)d_ws;
#if MK_FUSED
  void* args[] = {&p};
  hipError_t e = hipLaunchCooperativeKernel((const void*)k_mega, dim3(grid_blocks), dim3(NTHREADS), args, LDS_BYTES, stream);
  if (e != hipSuccess) fprintf(stderr, "cooperative launch failed: %s (grid %d)\n", hipGetErrorString(e), grid_blocks);
#else
  for (int ph = 0; ph < 12; ++ph) hipLaunchKernelGGL(k_phase, dim3(grid_blocks), dim3(NTHREADS), LDS_BYTES, stream, p, ph);
#endif
}
```

```cpp
#include <hip/hip_runtime.h>
#include <hip/hip_cooperative_groups.h>
#include <cstdio>
namespace cg = cooperative_groups;

#ifndef MK_FUSED
#define MK_FUSED 1
#endif

#define DI __device__ __forceinline__
typedef __attribute__((ext_vector_type(8))) short bf16x8;
typedef __attribute__((ext_vector_type(16))) float f32x16;
typedef __bf16 bf16_2 __attribute__((ext_vector_type(2)));
typedef float float_2 __attribute__((ext_vector_type(2)));
typedef unsigned short u16;
#define MFMA32(a, b, c) __builtin_amdgcn_mfma_f32_32x32x16_bf16((a), (b), (c), 0, 0, 0)

constexpr int NB = 32, SEQ = 2048, CTX = 256, TPB = SEQ + CTX;
constexpr int MT = NB * TPB;
constexpr int DM = 1024, DIN = 2976, NPAD = 3072;
constexpr float LOG2E = 1.4426950408889634f;
constexpr float NA_QS = 0.125f * LOG2E;
constexpr float MLA_QS = 0.10206207261596575f * LOG2E;
constexpr float EPS = 1e-6f;
constexpr int NTHREADS = 256;
constexpr int LDS_BYTES = 66560;

constexpr size_t al256(size_t x) { return (x + 255) & ~(size_t)255; }
constexpr size_t WS_CTL = 0;
constexpr size_t WS_MOD = 65536;
constexpr size_t WS_ROPE = WS_MOD + al256((size_t)2 * 33 * 3072 * 4);
constexpr size_t WS_WIN = WS_ROPE + (size_t)2 * 2048 * 16 * 4;
constexpr size_t WS_WUQ = WS_WIN + (size_t)2 * NPAD * 1024 * 2;
constexpr size_t WS_WUKV = WS_WUQ + (size_t)2 * 768 * 256 * 2;
constexpr size_t WS_WOUT = WS_WUKV + (size_t)2 * 1024 * 128 * 2;
constexpr size_t WS_H = WS_WOUT + (size_t)2 * 1024 * 1024 * 2;
constexpr size_t WS_QNA = WS_H + (size_t)MT * 1024 * 2;
constexpr size_t WS_KNA = WS_QNA + (size_t)MT * 512 * 2;
constexpr size_t WS_VTNA = WS_KNA + (size_t)MT * 512 * 2;
constexpr size_t WS_GNA = WS_VTNA + (size_t)MT * 512 * 2;
constexpr size_t WS_GMLA = WS_GNA + (size_t)MT * 512 * 2;
constexpr size_t WS_CQ = WS_GMLA + (size_t)MT * 512 * 2;
constexpr size_t WS_CKV = WS_CQ + (size_t)MT * 256 * 2;
constexpr size_t WS_KR = WS_CKV + (size_t)MT * 128 * 2;
constexpr size_t WS_QMLA = WS_KR + (size_t)MT * 32 * 4;
constexpr size_t WS_KMLA = WS_QMLA + (size_t)MT * 768 * 2;
constexpr size_t WS_VTMLA = WS_KMLA + (size_t)MT * 768 * 2;
constexpr size_t WS_CTX1 = WS_VTMLA + (size_t)MT * 512 * 2;
constexpr size_t WS_END = WS_CTX1 + (size_t)NB * CTX * 1024 * 4;
static_assert(WS_END <= (size_t)1073741824, "workspace");

struct Params {
  const float *x, *c, *ctx, *c_ctx, *norm_g, *w_ada, *b_ada, *w_in, *rpb, *q_norm_g, *w_uq, *kv_norm_g, *w_ukv, *w_out, *final_g;
  float* out;
  unsigned char* ws;
};

DI unsigned pack2(float a, float b) { float_2 f = {a, b}; bf16_2 r = __builtin_convertvector(f, bf16_2); return __builtin_bit_cast(unsigned, r); }
DI float bf2f(unsigned v) { return __uint_as_float(v << 16); }
DI float bflo(unsigned v) { return __uint_as_float(v << 16); }
DI float bfhi(unsigned v) { return __uint_as_float(v & 0xffff0000u); }
DI uint4 ldg16(const void* p) { return *reinterpret_cast<const uint4*>(p); }
DI bf16x8 as_frag(uint4 v) { return __builtin_bit_cast(bf16x8, v); }
DI float silu(float v) { return v / (1.f + __expf(-v)); }
DI int kappa(int i) { return (i & 0x13) | ((i & 4) << 1) | ((i & 8) >> 1); }
DI float wave_sum(float v) {
#pragma unroll
  for (int o = 32; o >= 1; o >>= 1) v += __shfl_xor(v, o);
  return v;
}

DI int remap_in(int n) { return n < 2432 ? n : (n < 2464 ? 2944 + (n - 2432) : 2432 + (n - 2464)); }
DI void transpose_item(int tid, const float* __restrict__ src, int K, int N, u16* __restrict__ dst, int k0, int n0, float* tile, int mode, const float* __restrict__ g) {
  const int t = tid;
  __syncthreads();
#pragma unroll 4
  for (int i = 0; i < 16; ++i) {
    const int kk = i * 4 + (t >> 6), nn = t & 63;
    float v = 0.f;
    if (n0 + nn < N) v = src[(size_t)(k0 + kk) * N + n0 + nn];
    if (mode == 2) v *= g[k0 + kk] * MLA_QS;
    if (mode == 3) v *= g[k0 + kk];
    if (mode == 0 && n0 + nn < 512) v *= NA_QS;
    tile[kk * 65 + nn] = v;
  }
  __syncthreads();
#pragma unroll 4
  for (int i = 0; i < 16; ++i) {
    const int nn = i * 4 + (t >> 6), kk = t & 63;
    const int n = n0 + nn;
    if (n < N) {
      const int nr = (mode == 0) ? remap_in(n) : (mode == 3 ? ((n & 64) ? 512 : 0) + (n >> 7) * 64 + (n & 63) : n);
      dst[(size_t)nr * K + k0 + kk] = (u16)(pack2(tile[kk * 65 + nn], 0.f) & 0xffffu);
    }
  }
}

DI void adaln_item(int tid, const Params& P, int l, int cc, float* sil) {
  const int t = tid, kg = t >> 5, cl = t & 31, n0 = cc * 32;
  float acc[33];
#pragma unroll
  for (int r = 0; r < 33; ++r) acc[r] = 0.f;
  const float* W = P.w_ada + (size_t)l * 1024 * 3072;
  for (int kq = 0; kq < 4; ++kq) {
    __syncthreads();
    for (int idx = t; idx < 33 * 256; idx += NTHREADS) {
      const int r = idx >> 8, kk = idx & 255;
      const float v = (r < 32) ? P.c[r * 1024 + kq * 256 + kk] : P.c_ctx[kq * 256 + kk];
      sil[idx] = silu(v);
    }
    __syncthreads();
    for (int kk = kg * 32; kk < kg * 32 + 32; ++kk) {
      const float w = W[(size_t)(kq * 256 + kk) * 3072 + n0 + cl];
#pragma unroll
      for (int r = 0; r < 33; ++r) acc[r] += sil[r * 256 + kk] * w;
    }
  }
  __syncthreads();
#pragma unroll
  for (int r = 0; r < 33; ++r) sil[(kg * 33 + r) * 32 + cl] = acc[r];
  __syncthreads();
  float* MOD = reinterpret_cast<float*>(P.ws + WS_MOD) + (size_t)l * 33 * 3072;
  for (int idx = t; idx < 33 * 32; idx += NTHREADS) {
    const int r = idx >> 5, c2 = idx & 31;
    float s = 0.f;
#pragma unroll
    for (int k2 = 0; k2 < 8; ++k2) s += sil[(k2 * 33 + r) * 32 + c2];
    MOD[r * 3072 + n0 + c2] = s + P.b_ada[l * 3072 + n0 + c2];
  }
}

constexpr int P0_ADA = 2 * 96, P0_TR_IN = 16 * 47, P0_TR_OUT = 256, P0_TR_UQ = 48, P0_TR_UKV = 32;
constexpr int P0_TR_L = P0_TR_IN + P0_TR_OUT + P0_TR_UQ + P0_TR_UKV;
constexpr int P0_PAD = 2, P0_ROPE = 128;
constexpr int P0_ITEMS = P0_ADA + 2 * P0_TR_L + P0_PAD + P0_ROPE;

DI void phase0(int tid, const Params& P, char* lds, int bid, int nblk) {
  float* fl = reinterpret_cast<float*>(lds);
  const int t = tid;
  for (int it = bid; it < P0_ITEMS; it += nblk) {
    int u = it;
    if (u < P0_ADA) { adaln_item(tid, P, u / 96, u % 96, fl); continue; }
    u -= P0_ADA;
    if (u < 2 * P0_TR_L) {
      const int l = u / P0_TR_L; int v = u % P0_TR_L;
      if (v < P0_TR_IN) {
        transpose_item(tid, P.w_in + (size_t)l * 1024 * DIN, 1024, DIN, reinterpret_cast<u16*>(P.ws + WS_WIN) + (size_t)l * NPAD * 1024, (v / 47) * 64, (v % 47) * 64, fl, 0, nullptr);
        continue;
      }
      v -= P0_TR_IN;
      if (v < P0_TR_OUT) {
        transpose_item(tid, P.w_out + (size_t)l * 1024 * 1024, 1024, 1024, reinterpret_cast<u16*>(P.ws + WS_WOUT) + (size_t)l * 1024 * 1024, (v / 16) * 64, (v % 16) * 64, fl, 1, nullptr);
        continue;
      }
      v -= P0_TR_OUT;
      if (v < P0_TR_UQ) {
        transpose_item(tid, P.w_uq + (size_t)l * 256 * 768, 256, 768, reinterpret_cast<u16*>(P.ws + WS_WUQ) + (size_t)l * 768 * 256, (v / 12) * 64, (v % 12) * 64, fl, 2, P.q_norm_g + l * 256);
        continue;
      }
      v -= P0_TR_UQ;
      transpose_item(tid, P.w_ukv + (size_t)l * 128 * 1024, 128, 1024, reinterpret_cast<u16*>(P.ws + WS_WUKV) + (size_t)l * 1024 * 128, (v / 16) * 64, (v % 16) * 64, fl, 3, P.kv_norm_g + l * 128);
      continue;
    }
    u -= 2 * P0_TR_L;
    if (u < P0_PAD) {
      uint4* d = reinterpret_cast<uint4*>(reinterpret_cast<u16*>(P.ws + WS_WIN) + ((size_t)u * NPAD + DIN) * 1024);
      for (int i = t; i < 96 * 1024 / 8; i += NTHREADS) d[i] = make_uint4(0, 0, 0, 0);
      continue;
    }
    u -= P0_PAD;
    {
      const int idx = u * 256 + t, pos = idx >> 4, p = idx & 15, row = pos >> 6, col = pos & 63, i = p & 7;
      const float inv = 1.0f / powf(10000.0f, (float)(2 * i) / 16.0f);
      const float ang = (float)(p < 8 ? row : col) * inv;
      float* R = reinterpret_cast<float*>(P.ws + WS_ROPE);
      R[idx] = cosf(ang);
      R[2048 * 16 + idx] = sinf(ang);
    }
  }
}

DI void phase_norm(int tid, const Params& P, int layer, int bid, int nblk) {
  const int t = tid, lane = t & 63, wave = __builtin_amdgcn_readfirstlane(t >> 6);
  const float* MOD = reinterpret_cast<const float*>(P.ws + WS_MOD) + (size_t)layer * 33 * 3072;
  const float* g = P.norm_g + layer * 1024;
  const float* xs = layer == 0 ? P.x : P.out;
  const float* cs = layer == 0 ? P.ctx : reinterpret_cast<const float*>(P.ws + WS_CTX1);
  u16* H = reinterpret_cast<u16*>(P.ws + WS_H);
  for (int row = bid * 4 + wave; row < MT; row += nblk * 4) {
    const int b = row / TPB, pos = row - b * TPB;
    const float* src = pos < SEQ ? xs + ((size_t)b * SEQ + pos) * 1024 : cs + ((size_t)b * CTX + (pos - SEQ)) * 1024;
    const float* md = MOD + (pos < SEQ ? b : 32) * 3072;
    float v[16];
#pragma unroll
    for (int q = 0; q < 2; ++q) {
      const float4 a = *reinterpret_cast<const float4*>(src + q * 512 + lane * 8);
      const float4 bq = *reinterpret_cast<const float4*>(src + q * 512 + lane * 8 + 4);
      v[q * 8 + 0] = a.x; v[q * 8 + 1] = a.y; v[q * 8 + 2] = a.z; v[q * 8 + 3] = a.w;
      v[q * 8 + 4] = bq.x; v[q * 8 + 5] = bq.y; v[q * 8 + 6] = bq.z; v[q * 8 + 7] = bq.w;
    }
    float ss = 0.f;
#pragma unroll
    for (int i = 0; i < 16; ++i) ss += v[i] * v[i];
    ss = wave_sum(ss);
    const float rstd = rsqrtf(ss * (1.f / 1024.f) + EPS);
#pragma unroll
    for (int q = 0; q < 2; ++q) {
      const int k = q * 512 + lane * 8;
      float o[8];
#pragma unroll
      for (int e = 0; e < 8; ++e) o[e] = v[q * 8 + e] * rstd * g[k + e] * (1.f + md[1024 + k + e]) + md[k + e];
      uint4 w;
      w.x = pack2(o[0], o[1]); w.y = pack2(o[2], o[3]); w.z = pack2(o[4], o[5]); w.w = pack2(o[6], o[7]);
      *reinterpret_cast<uint4*>(H + (size_t)row * 1024 + k) = w;
    }
  }
}

enum { EPI_INPROJ = 0, EPI_QPROJ = 1, EPI_KVPROJ = 2, EPI_OUTPROJ = 3 };

template <int EPI>
DI void epi_swapped(const Params& P, int layer, int m, int n, const float* v, float rs) {
  const int b = m / TPB, pos = m - b * TPB;
  if constexpr (EPI == EPI_INPROJ) {
    u16* dst; float o0 = v[0], o1 = v[1], o2 = v[2], o3 = v[3];
    if (n < 512) dst = reinterpret_cast<u16*>(P.ws + WS_QNA) + (size_t)m * 512 + n;
    else if (n < 1024) dst = reinterpret_cast<u16*>(P.ws + WS_KNA) + (size_t)m * 512 + (n - 512);
    else if (n < 2048) { dst = reinterpret_cast<u16*>(P.ws + WS_GNA) + (size_t)m * 512 + (n - 1536); o0 = silu(o0); o1 = silu(o1); o2 = silu(o2); o3 = silu(o3); }
    else if (n < 2304) dst = reinterpret_cast<u16*>(P.ws + WS_CQ) + (size_t)m * 256 + (n - 2048);
    else if (n < 2432) dst = reinterpret_cast<u16*>(P.ws + WS_CKV) + (size_t)m * 128 + (n - 2304);
    else if (n < 2944) { dst = reinterpret_cast<u16*>(P.ws + WS_GMLA) + (size_t)m * 512 + (n - 2432); o0 = silu(o0); o1 = silu(o1); o2 = silu(o2); o3 = silu(o3); }
    else if (n < 2976) { *reinterpret_cast<float4*>(reinterpret_cast<float*>(P.ws + WS_KR) + (size_t)m * 32 + (n - 2944)) = make_float4(o0, o1, o2, o3); return; }
    else return;
    *reinterpret_cast<uint2*>(dst) = make_uint2(pack2(o0, o1), pack2(o2, o3));
  } else if constexpr (EPI == EPI_QPROJ) {
    float o0 = v[0] * rs, o1 = v[1] * rs, o2 = v[2] * rs, o3 = v[3] * rs;
    const int dd = n % 96;
    if (dd >= 64 && pos < SEQ) {
      const float* R = reinterpret_cast<const float*>(P.ws + WS_ROPE);
      const int p0 = (dd - 64) >> 1;
      const float c0 = R[pos * 16 + p0], s0 = R[2048 * 16 + pos * 16 + p0], c1 = R[pos * 16 + p0 + 1], s1 = R[2048 * 16 + pos * 16 + p0 + 1];
      const float a0 = o0 * c0 - o1 * s0, a1 = o0 * s0 + o1 * c0, a2 = o2 * c1 - o3 * s1, a3 = o2 * s1 + o3 * c1;
      o0 = a0; o1 = a1; o2 = a2; o3 = a3;
    }
    *reinterpret_cast<uint2*>(reinterpret_cast<u16*>(P.ws + WS_QMLA) + (size_t)m * 768 + n) = make_uint2(pack2(o0, o1), pack2(o2, o3));
  } else if constexpr (EPI == EPI_KVPROJ) {
    const int hh = n >> 6, e = n & 63;
    u16* dst = reinterpret_cast<u16*>(P.ws + WS_KMLA) + (((size_t)b * 8 + hh) * TPB + pos) * 96 + e;
    *reinterpret_cast<uint2*>(dst) = make_uint2(pack2(v[0] * rs, v[1] * rs), pack2(v[2] * rs, v[3] * rs));
  } else {
    const float* MOD = reinterpret_cast<const float*>(P.ws + WS_MOD) + (size_t)layer * 33 * 3072;
    const float4 gt = *reinterpret_cast<const float4*>(MOD + (pos < SEQ ? b : 32) * 3072 + 2048 + n);
    const float* src; float* dst;
    if (pos < SEQ) { const size_t o = ((size_t)b * SEQ + pos) * 1024 + n; src = (layer == 0 ? P.x : P.out) + o; dst = P.out + o; }
    else { const size_t o = ((size_t)b * CTX + (pos - SEQ)) * 1024 + n; src = P.ctx + o; dst = reinterpret_cast<float*>(P.ws + WS_CTX1) + o; }
    const float4 xv = *reinterpret_cast<const float4*>(src);
    *reinterpret_cast<float4*>(dst) = make_float4(xv.x + gt.x * v[0], xv.y + gt.y * v[1], xv.z + gt.z * v[2], xv.w + gt.w * v[3]);
  }
}

template <int EPI>
DI void epi_natural(const Params& P, int m, int n, const float* v, const float* rsv) {
  const int b = m / TPB, pos = m - b * TPB;
  if constexpr (EPI == EPI_INPROJ) {
    const int vc = n - 1024, hh = vc >> 6, d = vc & 63;
    u16* dst = reinterpret_cast<u16*>(P.ws + WS_VTNA) + (((size_t)b * 8 + hh) * 64 + d) * TPB + pos;
    *reinterpret_cast<uint2*>(dst) = make_uint2(pack2(v[0], v[1]), pack2(v[2], v[3]));
  } else {
    const int hh = (n - 512) >> 6, d = n & 63;
    u16* dst = reinterpret_cast<u16*>(P.ws + WS_VTMLA) + (((size_t)b * 8 + hh) * 64 + d) * TPB + pos;
    *reinterpret_cast<uint2*>(dst) = make_uint2(pack2(v[0] * rsv[0], v[1] * rsv[1]), pack2(v[2] * rsv[2], v[3] * rsv[3]));
  }
}

template <int EPI, bool ROWNORM, bool NAT>
DI void gemm_tile(int tid, const Params& P, int layer, char* lds, const u16* __restrict__ A, int lda, const u16* __restrict__ Bt, int ldb, int K, int m0, int n0) {
  const int t = tid, lane = t & 63, wave = __builtin_amdgcn_readfirstlane(t >> 6), wm = wave >> 1, wn = wave & 1;
  const int l31 = lane & 31, h = lane >> 5;
  const int ld_row = t >> 3, ld_chk = t & 7;
  const unsigned st_off = ld_row * 128 + ((ld_chk ^ ((ld_row >> 1) & 7)) << 4);
  const int swz = (l31 >> 1) & 7;
  const unsigned a_off = (wm * 64 + l31) * 128, b_off = (wn * 64 + l31) * 128;
  float* rstd_s = reinterpret_cast<float*>(lds + 65536);


  const u16* gA = A + (size_t)(m0 + ld_row) * lda + ld_chk * 8;
  const u16* gB = Bt + (size_t)(n0 + ld_row) * ldb + ld_chk * 8;
  uint4 ra[4], rb[4];
  float ss[4] = {0.f, 0.f, 0.f, 0.f};
  f32x16 acc[2][2];
#pragma unroll
  for (int i = 0; i < 2; ++i)
#pragma unroll
    for (int j = 0; j < 2; ++j)
#pragma unroll
      for (int r = 0; r < 16; ++r) acc[i][j][r] = 0.f;

  const int KT = K / 64;
#pragma unroll
  for (int i = 0; i < 4; ++i) { ra[i] = ldg16(gA + (size_t)i * 32 * lda); rb[i] = ldg16(gB + (size_t)i * 32 * ldb); }
  for (int kt = 0; kt < KT; ++kt) {
    char* bufA = lds + (kt & 1) * 16384;
    char* bufB = lds + 32768 + (kt & 1) * 16384;
#pragma unroll
    for (int i = 0; i < 4; ++i) {
      *reinterpret_cast<uint4*>(bufA + st_off + i * 4096) = ra[i];
      *reinterpret_cast<uint4*>(bufB + st_off + i * 4096) = rb[i];
    }
    if constexpr (ROWNORM) {
#pragma unroll
      for (int i = 0; i < 4; ++i) {
        const unsigned w4[4] = {ra[i].x, ra[i].y, ra[i].z, ra[i].w};
#pragma unroll
        for (int e = 0; e < 4; ++e) { const float lo = bflo(w4[e]), hi = bfhi(w4[e]); ss[i] += lo * lo + hi * hi; }
      }
    }
    __syncthreads();
    if (kt + 1 < KT) {
#pragma unroll
      for (int i = 0; i < 4; ++i) { ra[i] = ldg16(gA + (size_t)i * 32 * lda + (kt + 1) * 64); rb[i] = ldg16(gB + (size_t)i * 32 * ldb + (kt + 1) * 64); }
    }
#pragma unroll
    for (int ks = 0; ks < 4; ++ks) {
      const unsigned co = ((ks * 2 + h) ^ swz) << 4;
      bf16x8 af[2], bfr[2];
#pragma unroll
      for (int i = 0; i < 2; ++i) {
        af[i] = as_frag(*reinterpret_cast<const uint4*>(bufA + a_off + i * 4096 + co));
        bfr[i] = as_frag(*reinterpret_cast<const uint4*>(bufB + b_off + i * 4096 + co));
      }
      if constexpr (NAT) {
#pragma unroll
        for (int i = 0; i < 2; ++i)
#pragma unroll
          for (int j = 0; j < 2; ++j) acc[i][j] = MFMA32(af[i], bfr[j], acc[i][j]);
      } else {
#pragma unroll
        for (int i = 0; i < 2; ++i)
#pragma unroll
          for (int j = 0; j < 2; ++j) acc[i][j] = MFMA32(bfr[j], af[i], acc[i][j]);
      }
    }
  }
  if constexpr (ROWNORM) {
#pragma unroll
    for (int i = 0; i < 4; ++i) {
      float s = ss[i];
      s += __shfl_xor(s, 1); s += __shfl_xor(s, 2); s += __shfl_xor(s, 4);
      if (ld_chk == 0) rstd_s[ld_row + 32 * i] = rsqrtf(s / (float)K + EPS);
    }
  }
  __syncthreads();

#pragma unroll
  for (int i = 0; i < 2; ++i)
#pragma unroll
    for (int j = 0; j < 2; ++j) {
      if constexpr (!NAT) {
        const int ml = wm * 64 + i * 32 + l31;
        float rs = 1.f;
        if constexpr (ROWNORM) rs = rstd_s[ml];
#pragma unroll
        for (int g = 0; g < 4; ++g) {
          const float v[4] = {acc[i][j][4 * g], acc[i][j][4 * g + 1], acc[i][j][4 * g + 2], acc[i][j][4 * g + 3]};
          epi_swapped<EPI>(P, layer, m0 + ml, n0 + wn * 64 + j * 32 + 8 * g + 4 * h, v, rs);
        }
      } else {
        if constexpr (EPI == EPI_INPROJ || EPI == EPI_KVPROJ) {
#pragma unroll
          for (int g = 0; g < 4; ++g) {
            const int ml = wm * 64 + i * 32 + 8 * g + 4 * h;
            const float v[4] = {acc[i][j][4 * g], acc[i][j][4 * g + 1], acc[i][j][4 * g + 2], acc[i][j][4 * g + 3]};
            float rsv[4] = {1.f, 1.f, 1.f, 1.f};
            if constexpr (ROWNORM) { rsv[0] = rstd_s[ml]; rsv[1] = rstd_s[ml + 1]; rsv[2] = rstd_s[ml + 2]; rsv[3] = rstd_s[ml + 3]; }
            epi_natural<EPI>(P, m0 + ml, n0 + wn * 64 + j * 32 + l31, v, rsv);
          }
        }
      }
    }
  if constexpr (EPI == EPI_KVPROJ && !NAT) {
    const int tok = t >> 1, half = t & 1, m = m0 + tok, b = m / TPB, pos = m - b * TPB, hh0 = n0 >> 6;
    const float* kr = reinterpret_cast<const float*>(P.ws + WS_KR) + (size_t)m * 32 + half * 16;
    float v[16];
#pragma unroll
    for (int q = 0; q < 4; ++q) { const float4 a = *reinterpret_cast<const float4*>(kr + q * 4); v[q * 4] = a.x; v[q * 4 + 1] = a.y; v[q * 4 + 2] = a.z; v[q * 4 + 3] = a.w; }
    if (pos < SEQ) {
      const float* R = reinterpret_cast<const float*>(P.ws + WS_ROPE);
#pragma unroll
      for (int pp = 0; pp < 8; ++pp) {
        const float c = R[pos * 16 + half * 8 + pp], s = R[2048 * 16 + pos * 16 + half * 8 + pp];
        const float a0 = v[2 * pp] * c - v[2 * pp + 1] * s, a1 = v[2 * pp] * s + v[2 * pp + 1] * c;
        v[2 * pp] = a0; v[2 * pp + 1] = a1;
      }
    }
    uint4 w0, w1;
    w0.x = pack2(v[0], v[1]); w0.y = pack2(v[2], v[3]); w0.z = pack2(v[4], v[5]); w0.w = pack2(v[6], v[7]);
    w1.x = pack2(v[8], v[9]); w1.y = pack2(v[10], v[11]); w1.z = pack2(v[12], v[13]); w1.w = pack2(v[14], v[15]);
#pragma unroll
    for (int q = 0; q < 2; ++q) {
      u16* dst = reinterpret_cast<u16*>(P.ws + WS_KMLA) + (((size_t)b * 8 + hh0 + q) * TPB + pos) * 96 + 64 + half * 16;
      *reinterpret_cast<uint4*>(dst) = w0;
      *reinterpret_cast<uint4*>(dst + 8) = w1;
    }
  }
}

constexpr int MTILES = MT / 128;

DI void phase_inproj(int tid, const Params& P, int layer, char* lds, int bid, int nblk) {
  const u16* A = reinterpret_cast<const u16*>(P.ws + WS_H);
  const u16* Bt = reinterpret_cast<const u16*>(P.ws + WS_WIN) + (size_t)layer * NPAD * 1024;
  for (int id = bid; id < MTILES * 24; id += nblk) {
    const int mt = id / 24, nt = id % 24;
    if (nt >= 8 && nt < 12) gemm_tile<EPI_INPROJ, false, true>(tid, P, layer, lds, A, 1024, Bt, 1024, 1024, mt * 128, nt * 128);
    else gemm_tile<EPI_INPROJ, false, false>(tid, P, layer, lds, A, 1024, Bt, 1024, 1024, mt * 128, nt * 128);
  }
}
DI void phase_subproj(int tid, const Params& P, int layer, char* lds, int bid, int nblk) {
  const u16* Aq = reinterpret_cast<const u16*>(P.ws + WS_CQ);
  const u16* Akv = reinterpret_cast<const u16*>(P.ws + WS_CKV);
  const u16* Bq = reinterpret_cast<const u16*>(P.ws + WS_WUQ) + (size_t)layer * 768 * 256;
  const u16* Bkv = reinterpret_cast<const u16*>(P.ws + WS_WUKV) + (size_t)layer * 1024 * 128;
  for (int id = bid; id < MTILES * 14; id += nblk) {
    const int mt = id / 14, nt = id % 14;
    if (nt < 6) gemm_tile<EPI_QPROJ, true, false>(tid, P, layer, lds, Aq, 256, Bq, 256, 256, mt * 128, nt * 128);
    else if (nt < 10) gemm_tile<EPI_KVPROJ, true, false>(tid, P, layer, lds, Akv, 128, Bkv, 128, 128, mt * 128, (nt - 6) * 128);
    else gemm_tile<EPI_KVPROJ, true, true>(tid, P, layer, lds, Akv, 128, Bkv, 128, 128, mt * 128, (nt - 6) * 128);
  }
}
DI void phase_outproj(int tid, const Params& P, int layer, char* lds, int bid, int nblk) {
  const u16* A = reinterpret_cast<const u16*>(P.ws + WS_H);
  const u16* Bt = reinterpret_cast<const u16*>(P.ws + WS_WOUT) + (size_t)layer * 1024 * 1024;
  for (int id = bid; id < MTILES * 8; id += nblk) {
    const int mt = id / 8, nt = id % 8;
    if (layer == 1 && (mt % 18) >= 16) continue;
    gemm_tile<EPI_OUTPROJ, false, false>(tid, P, layer, lds, A, 1024, Bt, 1024, 1024, mt * 128, nt * 128);
  }
}

struct AttnState { f32x16 o0, o1; float m, l; };

DI void attn_init(AttnState& st) {
#pragma unroll
  for (int r = 0; r < 16; ++r) { st.o0[r] = 0.f; st.o1[r] = 0.f; }
  st.m = -1e30f; st.l = 0.f;
}
DI void attn_tile(AttnState& st, f32x16 s, const u16* __restrict__ vt0, const u16* __restrict__ vt1, int h) {
  float mx = s[0];
#pragma unroll
  for (int r = 1; r < 16; ++r) mx = fmaxf(mx, s[r]);
  mx = fmaxf(mx, __shfl_xor(mx, 32));
  const float mn = fmaxf(st.m, mx);
  const float alpha = __builtin_amdgcn_exp2f(st.m - mn);
  st.m = mn;
  float p[16]; float sum = 0.f;
#pragma unroll
  for (int r = 0; r < 16; ++r) { p[r] = __builtin_amdgcn_exp2f(s[r] - mn); sum += p[r]; }
  st.l = st.l * alpha + sum;
#pragma unroll
  for (int r = 0; r < 16; ++r) { st.o0[r] *= alpha; st.o1[r] *= alpha; }
#pragma unroll
  for (int s2 = 0; s2 < 2; ++s2) {
    uint4 pw;
    pw.x = pack2(p[8 * s2], p[8 * s2 + 1]); pw.y = pack2(p[8 * s2 + 2], p[8 * s2 + 3]);
    pw.z = pack2(p[8 * s2 + 4], p[8 * s2 + 5]); pw.w = pack2(p[8 * s2 + 6], p[8 * s2 + 7]);
    const bf16x8 pf = as_frag(pw);
    const bf16x8 v0 = as_frag(ldg16(vt0 + 16 * s2 + 8 * h));
    const bf16x8 v1 = as_frag(ldg16(vt1 + 16 * s2 + 8 * h));
    st.o0 = MFMA32(v0, pf, st.o0);
    st.o1 = MFMA32(v1, pf, st.o1);
  }
}
DI void attn_store(const AttnState& st, const u16* __restrict__ grow, u16* __restrict__ orow, int h) {
  const float lt = st.l + __shfl_xor(st.l, 32);
  const float inv = 1.f / lt;
#pragma unroll
  for (int dt = 0; dt < 2; ++dt)
#pragma unroll
    for (int g = 0; g < 4; ++g) {
      const int d = dt * 32 + 8 * g + 4 * h;
      const uint2 gg = *reinterpret_cast<const uint2*>(grow + d);
      const f32x16& o = dt == 0 ? st.o0 : st.o1;
      const float a0 = o[4 * g] * inv * bflo(gg.x), a1 = o[4 * g + 1] * inv * bfhi(gg.x), a2 = o[4 * g + 2] * inv * bflo(gg.y), a3 = o[4 * g + 3] * inv * bfhi(gg.y);
      *reinterpret_cast<uint2*>(orow + d) = make_uint2(pack2(a0, a1), pack2(a2, a3));
    }
}

template <int NKS>
DI void dense_attn_wave(int tid, const u16* __restrict__ q, const u16* __restrict__ kbase, int k_ld, const u16* __restrict__ vt, int nkeys,
                        const u16* __restrict__ grow, u16* __restrict__ orow) {
  const int lane = tid & 63, l31 = lane & 31, h = lane >> 5;
  bf16x8 qf[NKS];
#pragma unroll
  for (int s = 0; s < NKS; ++s) qf[s] = as_frag(ldg16(q + 16 * s + 8 * h));
  AttnState st; attn_init(st);
  const u16* krow = kbase + (size_t)kappa(l31) * k_ld + 8 * h;
  const u16* vt0 = vt + (size_t)l31 * TPB;
  const u16* vt1 = vt + (size_t)(32 + l31) * TPB;
  for (int kb = 0; kb < nkeys; kb += 32) {
    f32x16 s;
#pragma unroll
    for (int r = 0; r < 16; ++r) s[r] = 0.f;
#pragma unroll
    for (int ks = 0; ks < NKS; ++ks) s = MFMA32(as_frag(ldg16(krow + (size_t)kb * k_ld + 16 * ks)), qf[ks], s);
    attn_tile(st, s, vt0 + kb, vt1 + kb, h);
  }
  attn_store(st, grow, orow, h);
}

DI float xhalf_max(float x) {
  auto r = __builtin_amdgcn_permlane32_swap(__float_as_uint(x), __float_as_uint(x), false, false);
  return fmaxf(__uint_as_float(r[0]), __uint_as_float(r[1]));
}

constexpr int ATT_STAGE = 13312 + 8192;
constexpr float ATT_THR = 4.0f;
template <int NKS>
DI void dense_attn_block(int tid, char* lds, const u16* __restrict__ qbase, int q_ld, const u16* __restrict__ kbase, int k_ld,
                         const u16* __restrict__ vt, int nkeys, const u16* __restrict__ gbase, int g_ld, u16* __restrict__ obase, int o_ld) {
  constexpr int KPITCH = NKS * 32 + 16;
  constexpr int CPR = NKS * 2;
  const int lane = tid & 63, wave = __builtin_amdgcn_readfirstlane(tid >> 6), l31 = lane & 31, h = lane >> 5;
  bf16x8 qf[2][NKS];
#pragma unroll
  for (int sub = 0; sub < 2; ++sub)
#pragma unroll
    for (int s = 0; s < NKS; ++s) qf[sub][s] = as_frag(ldg16(qbase + (size_t)(wave * 64 + sub * 32 + l31) * q_ld + 16 * s + 8 * h));
  f32x16 o[2][2];
  float m[2] = {-1e30f, -1e30f}, l[2] = {0.f, 0.f};
#pragma unroll
  for (int sub = 0; sub < 2; ++sub)
#pragma unroll
    for (int dt = 0; dt < 2; ++dt)
#pragma unroll
      for (int r = 0; r < 16; ++r) o[sub][dt][r] = 0.f;
  constexpr int NKI = (64 * KPITCH) / 1024;
  unsigned koff[4], voff[2];
#pragma unroll
  for (int i = 0; i < 4; ++i) {
    const unsigned off = (wave + 4 * i) * 1024 + lane * 16;
    const unsigned row = off / KPITCH, c = (off - row * KPITCH) >> 4;
    koff[i] = row * k_ld + (c < (unsigned)CPR ? c : 0u) * 8;
  }
#pragma unroll
  for (int i = 0; i < 2; ++i) {
    const unsigned off = (wave + 4 * i) * 1024 + lane * 16;
    const unsigned row = off >> 7, c = ((off >> 4) & 7) ^ ((row >> 1) & 7);
    voff[i] = row * TPB + c * 8;
  }
  const unsigned ka0 = kappa(l31) * KPITCH + h * 16;
  const unsigned va0 = 13312 + l31 * 128;
  const int swz = (l31 >> 1) & 7;
  const int NT = nkeys >> 6;
  __syncthreads();
#define ATT_STAGE_ISSUE(T_, BUF_) do { \
    char* sb_ = lds + (BUF_) * ATT_STAGE + wave * 1024; \
    const u16* kb_ = kbase + (size_t)(T_) * 64 * k_ld; \
    const u16* vb_ = vt + (T_) * 64; \
    _Pragma("unroll") for (int i_ = 0; i_ < 4; ++i_) \
      if (wave + 4 * i_ < NKI) __builtin_amdgcn_global_load_lds((const unsigned*)(kb_ + koff[i_]), (unsigned*)(sb_ + i_ * 4096), 16, 0, 0); \
    _Pragma("unroll") for (int i_ = 0; i_ < 2; ++i_) \
      __builtin_amdgcn_global_load_lds((const unsigned*)(vb_ + voff[i_]), (unsigned*)(sb_ + 13312 + i_ * 4096), 16, 0, 0); \
  } while (0)
  ATT_STAGE_ISSUE(0, 0);
  for (int t = 0; t < NT; ++t) {
    char* buf = lds + (t & 1) * ATT_STAGE;
    asm volatile("s_waitcnt vmcnt(0)" ::: "memory");
    __syncthreads();
    if (t + 1 < NT) ATT_STAGE_ISSUE(t + 1, (t + 1) & 1);
#pragma unroll
    for (int kt = 0; kt < 2; ++kt) {
      f32x16 s[2];
#pragma unroll
      for (int sub = 0; sub < 2; ++sub)
#pragma unroll
        for (int r = 0; r < 16; ++r) s[sub][r] = 0.f;
#pragma unroll
      for (int ks = 0; ks < NKS; ++ks) {
        const bf16x8 kf = as_frag(*reinterpret_cast<const uint4*>(buf + ka0 + kt * 32 * KPITCH + ks * 32));
        s[0] = MFMA32(kf, qf[0][ks], s[0]);
        s[1] = MFMA32(kf, qf[1][ks], s[1]);
      }
      uint4 pw[2][2];
#pragma unroll
      for (int sub = 0; sub < 2; ++sub) {
        float mx = s[sub][0];
#pragma unroll
        for (int r = 1; r < 16; ++r) mx = fmaxf(mx, s[sub][r]);
        mx = xhalf_max(mx);
        if (__any(mx > m[sub] + ATT_THR)) {
          const float mn = fmaxf(m[sub], mx);
          const float alpha = __builtin_amdgcn_exp2f(m[sub] - mn);
          m[sub] = mn;
          l[sub] *= alpha;
#pragma unroll
          for (int r = 0; r < 16; ++r) { o[sub][0][r] *= alpha; o[sub][1][r] *= alpha; }
        }
        const float mm = m[sub];
        float sum = 0.f;
        float p[16];
#pragma unroll
        for (int r = 0; r < 16; ++r) { p[r] = __builtin_amdgcn_exp2f(s[sub][r] - mm); sum += p[r]; }
#pragma unroll
        for (int s2 = 0; s2 < 2; ++s2) {
          uint4 w;
          w.x = pack2(p[8 * s2], p[8 * s2 + 1]); w.y = pack2(p[8 * s2 + 2], p[8 * s2 + 3]);
          w.z = pack2(p[8 * s2 + 4], p[8 * s2 + 5]); w.w = pack2(p[8 * s2 + 6], p[8 * s2 + 7]);
          pw[sub][s2] = w;
        }
        l[sub] += sum;
      }
#pragma unroll
      for (int s2 = 0; s2 < 2; ++s2) {
        const unsigned co = ((2 * (kt * 2 + s2) + h) ^ swz) << 4;
        const bf16x8 v0 = as_frag(*reinterpret_cast<const uint4*>(buf + va0 + co));
        const bf16x8 v1 = as_frag(*reinterpret_cast<const uint4*>(buf + va0 + 4096 + co));
        o[0][0] = MFMA32(v0, as_frag(pw[0][s2]), o[0][0]);
        o[0][1] = MFMA32(v1, as_frag(pw[0][s2]), o[0][1]);
        o[1][0] = MFMA32(v0, as_frag(pw[1][s2]), o[1][0]);
        o[1][1] = MFMA32(v1, as_frag(pw[1][s2]), o[1][1]);
      }
    }
  }
#pragma unroll
  for (int sub = 0; sub < 2; ++sub) {
    const float lt = l[sub] + __shfl_xor(l[sub], 32);
    const float inv = 1.f / lt;
    const size_t row = (size_t)(wave * 64 + sub * 32 + l31);
#pragma unroll
    for (int dt = 0; dt < 2; ++dt)
#pragma unroll
      for (int g = 0; g < 4; ++g) {
        const int d = dt * 32 + 8 * g + 4 * h;
        const uint2 gg = *reinterpret_cast<const uint2*>(gbase + row * g_ld + d);
        const float a0 = o[sub][dt][4 * g] * inv * bflo(gg.x), a1 = o[sub][dt][4 * g + 1] * inv * bfhi(gg.x);
        const float a2 = o[sub][dt][4 * g + 2] * inv * bflo(gg.y), a3 = o[sub][dt][4 * g + 3] * inv * bfhi(gg.y);
        *reinterpret_cast<uint2*>(obase + row * o_ld + d) = make_uint2(pack2(a0, a1), pack2(a2, a3));
      }
  }
}

DI void na_wave(int tid, const Params& P, const float* bias, int b, int hh, int rp, int j) {
  const int lane = tid & 63, l31 = lane & 31, h = lane >> 5;
  const int qrow = 2 * rp + (l31 >> 4), qcol = 16 * j + (l31 & 15);
  const int pos = qrow * 64 + qcol;
  const size_t T = (size_t)b * TPB + pos;
  const u16* QNA = reinterpret_cast<const u16*>(P.ws + WS_QNA);
  const u16* KNA = reinterpret_cast<const u16*>(P.ws + WS_KNA) + (size_t)b * TPB * 512 + hh * 64;
  const u16* VT = reinterpret_cast<const u16*>(P.ws + WS_VTNA) + ((size_t)b * 8 + hh) * 64 * TPB;
  bf16x8 qf[4];
#pragma unroll
  for (int s = 0; s < 4; ++s) qf[s] = as_frag(ldg16(QNA + T * 512 + hh * 64 + 16 * s + 8 * h));
  const int rs_q = min(max(qrow - 4, 0), 24), qcs = min(max(qcol - 8, 0), 48);
  const int rsA = min(max(2 * rp - 4, 0), 24), rsB = min(max(2 * rp - 3, 0), 24);
  const int nrows = 8 + rsB - rsA;
  const int cb = (j == 0) ? 0 : (j == 1 ? 8 : (j == 2 ? 24 : 32));
  AttnState st; attn_init(st);
  const u16* vt0 = VT + (size_t)l31 * TPB;
  const u16* vt1 = VT + (size_t)(32 + l31) * TPB;
  const int kap = kappa(l31);
  for (int tb = SEQ; tb < TPB; tb += 32) {
    f32x16 s;
#pragma unroll
    for (int r = 0; r < 16; ++r) s[r] = 0.f;
    const u16* krow = KNA + (size_t)(tb + kap) * 512 + 8 * h;
#pragma unroll
    for (int ks = 0; ks < 4; ++ks) s = MFMA32(as_frag(ldg16(krow + 16 * ks)), qf[ks], s);
    attn_tile(st, s, vt0 + tb, vt1 + tb, h);
  }
  for (int w = 0; w < nrows; ++w) {
    const int kr = rsA + w, tb = kr * 64 + cb;
    f32x16 s;
#pragma unroll
    for (int r = 0; r < 16; ++r) s[r] = 0.f;
    const u16* krow = KNA + (size_t)(tb + kap) * 512 + 8 * h;
#pragma unroll
    for (int ks = 0; ks < 4; ++ks) s = MFMA32(as_frag(ldg16(krow + 16 * ks)), qf[ks], s);
    const bool row_ok = (kr >= rs_q) && (kr < rs_q + 8);
    const int bbase = (kr - qrow + 7) * 31 + (cb - qcol + 15);
#pragma unroll
    for (int r = 0; r < 16; ++r) {
      const int ko = (r & 7) + 8 * h + 16 * (r >> 3);
      const int kc = cb + ko;
      const bool ok = row_ok && (kc >= qcs) && (kc < qcs + 16);
      const float bv = bias[ok ? (bbase + ko) : 0];
      s[r] = ok ? (s[r] + bv) : -1e30f;
    }
    attn_tile(st, s, vt0 + tb, vt1 + tb, h);
  }
  attn_store(st, reinterpret_cast<const u16*>(P.ws + WS_GNA) + T * 512 + hh * 64, reinterpret_cast<u16*>(P.ws + WS_H) + T * 1024 + hh * 64, h);
}

constexpr int N_MLA_U = NB * 8 * 8;
constexpr int N_NA_U = NB * 8 * 16;
constexpr int N_CTX_U = NB * 8;

DI void phase_attn(int tid, const Params& P, int layer, char* lds, int bid, int nblk) {
  const int t = tid, wave = __builtin_amdgcn_readfirstlane(t >> 6);
  float* bias = reinterpret_cast<float*>(lds);
  const int total = N_MLA_U + N_NA_U + (layer == 0 ? 2 * N_CTX_U : 0);
  const u16* QM = reinterpret_cast<const u16*>(P.ws + WS_QMLA);
  const u16* KM = reinterpret_cast<const u16*>(P.ws + WS_KMLA);
  const u16* VM = reinterpret_cast<const u16*>(P.ws + WS_VTMLA);
  const u16* GM = reinterpret_cast<const u16*>(P.ws + WS_GMLA);
  u16* MIX = reinterpret_cast<u16*>(P.ws + WS_H);
  const int vb = ((nblk & 7) == 0) ? (bid & 7) * (nblk >> 3) + (bid >> 3) : bid;
  for (int u = vb; u < total; u += nblk) {
    if (u < N_MLA_U) {
      const int b = u >> 6, hh = (u >> 3) & 7, qb = u & 7;
      const size_t T0 = (size_t)b * TPB + qb * 256;
      dense_attn_block<6>(tid, lds, QM + T0 * 768 + hh * 96, 768, KM + ((size_t)b * 8 + hh) * TPB * 96, 96, VM + ((size_t)b * 8 + hh) * 64 * TPB, TPB,
                          GM + T0 * 512 + hh * 64, 512, MIX + T0 * 1024 + 512 + hh * 64, 1024);
    } else if (u < N_MLA_U + N_NA_U) {
      const int v = u - N_MLA_U, b = v >> 7, hh = (v >> 4) & 7, rp = v & 15;
      __syncthreads();
      for (int i = t; i < 15 * 31; i += NTHREADS) bias[i] = P.rpb[((size_t)layer * 8 + hh) * 465 + i] * LOG2E;
      __syncthreads();
      na_wave(tid, P, bias, b, hh, rp, wave);
    } else {
      int v = u - N_MLA_U - N_NA_U;
      const bool is_na = v >= N_CTX_U; if (is_na) v -= N_CTX_U;
      const int b = v >> 3, hh = v & 7;
      const size_t T0 = (size_t)b * TPB + SEQ;
      if (!is_na) {
        dense_attn_block<6>(tid, lds, QM + T0 * 768 + hh * 96, 768, KM + (((size_t)b * 8 + hh) * TPB + SEQ) * 96, 96, VM + ((size_t)b * 8 + hh) * 64 * TPB + SEQ, CTX,
                            GM + T0 * 512 + hh * 64, 512, MIX + T0 * 1024 + 512 + hh * 64, 1024);
      } else {
        dense_attn_block<4>(tid, lds, reinterpret_cast<const u16*>(P.ws + WS_QNA) + T0 * 512 + hh * 64, 512,
                            reinterpret_cast<const u16*>(P.ws + WS_KNA) + T0 * 512 + hh * 64, 512,
                            reinterpret_cast<const u16*>(P.ws + WS_VTNA) + ((size_t)b * 8 + hh) * 64 * TPB + SEQ, CTX,
                            reinterpret_cast<const u16*>(P.ws + WS_GNA) + T0 * 512 + hh * 64, 512, MIX + T0 * 1024 + hh * 64, 1024);
      }
    }
  }
}

DI void phase_final(int tid, const Params& P, int bid, int nblk) {
  const int t = tid, lane = t & 63, wave = __builtin_amdgcn_readfirstlane(t >> 6);
  for (int row = bid * 4 + wave; row < NB * SEQ; row += nblk * 4) {
    float* src = P.out + (size_t)row * 1024;
    float4 v[4];
    float ss = 0.f;
#pragma unroll
    for (int q = 0; q < 4; ++q) { v[q] = *reinterpret_cast<const float4*>(src + q * 256 + lane * 4); ss += v[q].x * v[q].x + v[q].y * v[q].y + v[q].z * v[q].z + v[q].w * v[q].w; }
    ss = wave_sum(ss);
    const float rstd = rsqrtf(ss * (1.f / 1024.f) + EPS);
#pragma unroll
    for (int q = 0; q < 4; ++q) {
      const float4 g = *reinterpret_cast<const float4*>(P.final_g + q * 256 + lane * 4);
      *reinterpret_cast<float4*>(src + q * 256 + lane * 4) = make_float4(v[q].x * rstd * g.x, v[q].y * rstd * g.y, v[q].z * rstd * g.z, v[q].w * rstd * g.w);
    }
  }
}

#define XB_TMO      128
#define XB_XCNT(j)  (256  + 64 * (j))
#define XB_XSUB(j)  (1280 + 64 * (j))
#define XB_XGEN(j)  (2304 + 64 * (j))
#define XB_TOP      3328
#define XB_TOPGEN   3392
#define XCD_BAR_WORDS 3456
#define XB_SPIN_CAP (1u << 22)
#define LAS __attribute__((address_space(3)))
DI unsigned xb_ld(unsigned* p)              { return __hip_atomic_load(p, __ATOMIC_RELAXED, __HIP_MEMORY_SCOPE_AGENT); }
DI unsigned xb_add(unsigned* p, unsigned v) { return __hip_atomic_fetch_add(p, v, __ATOMIC_RELAXED, __HIP_MEMORY_SCOPE_AGENT); }
DI unsigned xb_xcc_id() { return (unsigned)__builtin_amdgcn_s_getreg((3 << 11) | 20) & 0xFu; }
#define XB_SPIN(cond, bar) do { unsigned _sp = 0; while (cond) { __builtin_amdgcn_s_sleep(1); \
    if ((++_sp & 255u) == 0u) { if (xb_ld(&(bar)[XB_TMO])) break; if (_sp > XB_SPIN_CAP) { atomicAdd(&(bar)[XB_TMO], 1u); break; } } } } while (0)
struct XcdBarrier { unsigned* bar; unsigned x; volatile LAS unsigned* st; };
DI XcdBarrier xcd_barrier_post(unsigned* bar, volatile LAS unsigned* st) {
  XcdBarrier b; b.bar = bar; b.x = xb_xcc_id(); b.st = st;
  if (threadIdx.x == 0) (void)xb_add(&bar[XB_XCNT(b.x)], 1u);
  return b;
}
DI void xcd_barrier_complete(unsigned* bar, unsigned x, unsigned& nloc, unsigned& nx) {
  const unsigned G = gridDim.x * gridDim.y * gridDim.z;
  unsigned sum, cnt, mine, sp = 0u;
  for (;;) {
    sum = 0u; cnt = 0u; mine = 0u;
#pragma unroll
    for (unsigned j = 0; j < 16; ++j) { const unsigned c = xb_ld(&bar[XB_XCNT(j)]); sum += c; cnt += (c > 0u) ? 1u : 0u; mine = (j == x) ? c : mine; }
    if (sum == G) break;
    __builtin_amdgcn_s_sleep(1);
    if ((++sp & 255u) == 0u) { if (xb_ld(&bar[XB_TMO])) break; if (sp > XB_SPIN_CAP) { atomicAdd(&bar[XB_TMO], 1u); break; } }
  }
  nloc = mine > 0u ? mine : 1u; nx = cnt > 0u ? cnt : 1u;
}
DI void xcd_barrier(const XcdBarrier& b) {
  asm volatile("s_waitcnt vmcnt(0)" ::: "memory");
  __syncthreads();
  if (threadIdx.x == 0) {
    unsigned* bar = b.bar;
    __builtin_amdgcn_s_waitcnt(0);
    unsigned nloc = b.st[0], nx = b.st[1];
    if (nloc == 0u) { xcd_barrier_complete(bar, b.x, nloc, nx); b.st[0] = nloc; b.st[1] = nx; }
    const unsigned old = xb_add(&bar[XB_XSUB(b.x)], 1u);
    const unsigned gen = old / nloc;
    if (old + 1u == (gen + 1u) * nloc) {
      __builtin_amdgcn_fence(__ATOMIC_RELEASE, "agent");
      asm volatile("s_waitcnt vmcnt(0)" ::: "memory");
      const unsigned og = xb_add(&bar[XB_TOP], 1u);
      const unsigned tg = og / nx;
      if (og + 1u == (tg + 1u) * nx) xb_add(&bar[XB_TOPGEN], 1u);
      else XB_SPIN(xb_ld(&bar[XB_TOPGEN]) == tg, bar);
      __builtin_amdgcn_fence(__ATOMIC_ACQUIRE, "agent");
      xb_add(&bar[XB_XGEN(b.x)], 1u);
      asm volatile("s_waitcnt vmcnt(0)" ::: "memory");
    } else {
      XB_SPIN(xb_ld(&bar[XB_XGEN(b.x)]) == gen, bar);
      __builtin_amdgcn_fence(__ATOMIC_ACQUIRE, "agent");
      asm volatile("s_waitcnt vmcnt(0)" ::: "memory");
    }
  }
  __syncthreads();
}

DI void run_phase(int tid, const Params& P, int ph, char* lds, int bid, int nblk) {
#ifndef ONLY_K
#define ONLY_K -1
#endif
  if (ph == 0) { if (ONLY_K < 0 || ONLY_K == 5) phase0(tid, P, lds, bid, nblk); return; }
  if (ph == 11) { if (ONLY_K < 0 || ONLY_K == 6) phase_final(tid, P, bid, nblk); return; }
  const int layer = (ph - 1) / 5, k = (ph - 1) % 5;
  if (k == 0) { if (ONLY_K < 0 || ONLY_K == 0) phase_norm(tid, P, layer, bid, nblk); }
  else if (k == 1) { if (ONLY_K < 0 || ONLY_K == 1) phase_inproj(tid, P, layer, lds, bid, nblk); }
  else if (k == 2) { if (ONLY_K < 0 || ONLY_K == 2) phase_subproj(tid, P, layer, lds, bid, nblk); }
  else if (k == 3) { if (ONLY_K < 0 || ONLY_K == 3) phase_attn(tid, P, layer, lds, bid, nblk); }
  else { if (ONLY_K < 0 || ONLY_K == 4) phase_outproj(tid, P, layer, lds, bid, nblk); }
}

__global__ void __launch_bounds__(NTHREADS, 2) k_phase(Params P, int ph) {
  extern __shared__ __attribute__((aligned(16))) char lds[];
  const int tid = threadIdx.x;
  run_phase(tid, P, ph, lds, blockIdx.x, gridDim.x);
}

#if MK_FUSED
__global__ void __launch_bounds__(NTHREADS, 2) k_mega(Params P) {
  extern __shared__ __attribute__((aligned(16))) char lds[];
  cg::grid_group grid = cg::this_grid();
  volatile LAS unsigned* st = (volatile LAS unsigned*)(lds + 66048);
  if (threadIdx.x == 0) { st[0] = 0u; st[1] = 0u; }
  __syncthreads();
  const XcdBarrier bar = xcd_barrier_post(reinterpret_cast<unsigned*>(P.ws + WS_CTL), st);
#pragma unroll 1
  for (int ph = 0; ph < 12; ++ph) {
    int tid = threadIdx.x;
    asm volatile("" : "+v"(tid));
    tid &= 255;
    run_phase(tid, P, ph, lds, blockIdx.x, gridDim.x);
    if (ph == 0) grid.sync();
    else if (ph < 11) xcd_barrier(bar);
  }
}
#endif

extern "C" void kernel_launch(void* const* d_in, const int* in_sizes, int n_in, void* d_out, int out_size, void* d_ws, size_t ws_size, hipStream_t stream) {
  static int grid_blocks = 0;
  if (!grid_blocks) {
    int dev = 0, cus = 0, per_cu = 0;
    (void)hipGetDevice(&dev);
    (void)hipDeviceGetAttribute(&cus, hipDeviceAttributeMultiprocessorCount, dev);
#if MK_FUSED
    (void)hipFuncSetAttribute((const void*)k_mega, hipFuncAttributeMaxDynamicSharedMemorySize, LDS_BYTES);
#endif
    (void)hipFuncSetAttribute((const void*)k_phase, hipFuncAttributeMaxDynamicSharedMemorySize, LDS_BYTES);
#if MK_FUSED
    (void)hipOccupancyMaxActiveBlocksPerMultiprocessor(&per_cu, (const void*)k_mega, NTHREADS, LDS_BYTES);
#else
    (void)hipOccupancyMaxActiveBlocksPerMultiprocessor(&per_cu, (const void*)k_phase, NTHREADS, LDS_BYTES);
#endif
    if (per_cu > 2) per_cu = 2;
    if (per_cu < 1) per_cu = 1;
    grid_blocks = cus * per_cu;
  }
  Params p{};
  p.x = (const float*)d_in[0]; p.c = (const float*)d_in[1]; p.ctx = (const float*)d_in[2]; p.c_ctx = (const float*)d_in[3];
  p.norm_g = (const float*)d_in[4]; p.w_ada = (const float*)d_in[5]; p.b_ada = (const float*)d_in[6]; p.w_in = (const float*)d_in[7];
  p.rpb = (const float*)d_in[8]; p.q_norm_g = (const float*)d_in[9]; p.w_uq = (const float*)d_in[10]; p.kv_norm_g = (const float*)d_in[11];
  p.w_ukv = (const float*)d_in[12]; p.w_out = (const float*)d_in[13]; p.final_g = (const float*)d_in[14];
  p.out = (float*)d_out; p.ws = (unsigned char*)d_ws;
#if MK_FUSED
  (void)hipMemsetAsync((char*)d_ws + WS_CTL, 0, 16384, stream);
  void* args[] = {&p};
  hipError_t e = hipLaunchCooperativeKernel((const void*)k_mega, dim3(grid_blocks), dim3(NTHREADS), args, LDS_BYTES, stream);
  if (e != hipSuccess) fprintf(stderr, "cooperative launch failed: %s (grid %d)\n", hipGetErrorString(e), grid_blocks);
#else
  for (int ph = 0; ph < 12; ++ph) hipLaunchKernelGGL(k_phase, dim3(grid_blocks), dim3(NTHREADS), LDS_BYTES, stream, p, ph);
#endif
}
```

```cpp
#include <hip/hip_runtime.h>
#include <hip/hip_cooperative_groups.h>
#include <cstdio>
namespace cg = cooperative_groups;

#ifndef MK_FUSED
#define MK_FUSED 1
#endif

#define DI __device__ __forceinline__
typedef __attribute__((ext_vector_type(8))) short bf16x8;
typedef __attribute__((ext_vector_type(16))) float f32x16;
typedef __bf16 bf16_2 __attribute__((ext_vector_type(2)));
typedef float float_2 __attribute__((ext_vector_type(2)));
typedef unsigned short u16;
#define MFMA32(a, b, c) __builtin_amdgcn_mfma_f32_32x32x16_bf16((a), (b), (c), 0, 0, 0)

constexpr int NB = 32, SEQ = 2048, CTX = 256, TPB = SEQ + CTX;
constexpr int MT = NB * TPB;
constexpr int DM = 1024, DIN = 2976;
constexpr int NIN = 3072;
constexpr float LOG2E = 1.4426950408889634f;
constexpr float NA_QS = 0.125f * LOG2E;
constexpr float MLA_QS = 0.10206207261596575f * LOG2E;
constexpr float EPS = 1e-6f;
constexpr int NTHREADS = 512, NWAVES = 8;
constexpr int LDS_WORK = 131072;
constexpr int LDS_BYTES = LDS_WORK + 512;


constexpr size_t al256(size_t x) { return (x + 255) & ~(size_t)255; }
constexpr size_t WS_CTL = 0;
constexpr size_t WS_MOD = 65536;
constexpr size_t WS_ROPE = WS_MOD + al256((size_t)2 * 33 * 3072 * 4);
constexpr size_t WS_WIN = WS_ROPE + (size_t)2 * 2048 * 16 * 4;
constexpr size_t WS_WUQ = WS_WIN + (size_t)2 * 3072 * 1024 * 2;
constexpr size_t WS_WUKV = WS_WUQ + (size_t)2 * 768 * 256 * 2;
constexpr size_t WS_WOUT = WS_WUKV + (size_t)2 * 1024 * 256 * 2;
constexpr size_t WS_H = WS_WOUT + (size_t)2 * 1024 * 1024 * 2;
constexpr size_t WS_QNA = WS_H + (size_t)MT * 1024 * 2;
constexpr size_t WS_KNA = WS_QNA + (size_t)MT * 512 * 2;
constexpr size_t WS_VTNA = WS_KNA + (size_t)MT * 512 * 2;
constexpr size_t WS_GNA = WS_VTNA + (size_t)MT * 512 * 2;
constexpr size_t WS_GMLA = WS_GNA + (size_t)MT * 512 * 2;
constexpr size_t WS_CQKV = WS_GMLA + (size_t)MT * 512 * 2;
constexpr size_t WS_QMLA = WS_CQKV + (size_t)MT * 384 * 2;
constexpr size_t WS_KMLA = WS_QMLA + (size_t)MT * 768 * 2;
constexpr size_t WS_VTMLA = WS_KMLA + (size_t)MT * 768 * 2;
constexpr size_t WS_CTX1 = WS_VTMLA + (size_t)MT * 512 * 2;
constexpr size_t WS_SSQ = WS_CTX1 + (size_t)NB * CTX * 1024 * 4;
constexpr size_t WS_SSKV = WS_SSQ + (size_t)MT * 8 * 4;
constexpr size_t WS_END = WS_SSKV + (size_t)MT * 4 * 4;
constexpr size_t WS_X2 = WS_QNA;
static_assert((size_t)NB * SEQ * 1024 * 2 <= WS_VTNA - WS_QNA, "x2 overlay");
static_assert(WS_END <= (size_t)1073741824, "workspace");

struct Params {
  const float *x, *c, *ctx, *c_ctx, *norm_g, *w_ada, *b_ada, *w_in, *rpb, *q_norm_g, *w_uq, *kv_norm_g, *w_ukv, *w_out, *final_g;
  float* out;
  unsigned char* ws;
};

DI unsigned pack2(float a, float b) { float_2 f = {a, b}; bf16_2 r = __builtin_convertvector(f, bf16_2); return __builtin_bit_cast(unsigned, r); }
DI float bflo(unsigned v) { return __uint_as_float(v << 16); }
DI float bfhi(unsigned v) { return __uint_as_float(v & 0xffff0000u); }
DI uint4 ldg16(const void* p) { return *reinterpret_cast<const uint4*>(p); }
DI bf16x8 as_frag(uint4 v) { return __builtin_bit_cast(bf16x8, v); }
DI float silu(float v) { return v * __builtin_amdgcn_rcpf(1.f + __builtin_amdgcn_exp2f(-LOG2E * v)); }
DI int kappa(int i) { return (i & 0x13) | ((i & 4) << 1) | ((i & 8) >> 1); }
DI float wave_sum(float v) {
#pragma unroll
  for (int o = 32; o >= 1; o >>= 1) v += __shfl_xor(v, o);
  return v;
}

DI int remap_in(int n) {
  return n < 512 ? 768 + n : n < 1024 ? n - 512 : n < 1536 ? 2560 + (n - 1024) : n < 2048 ? 1280 + (n - 1536) : n < 2304 ? 1792 + (n - 2048)
       : n < 2432 ? 512 + (n - 2304) : n < 2464 ? 640 + (n - 2432) : 2048 + (n - 2464);
}
DI void transpose_item(int tid, const float* __restrict__ src, int K, int N, u16* __restrict__ dst, int dstK, int k0, int n0, float* tile, int mode, const float* __restrict__ g) {
  const int t = tid;
  float v[4][8];
#pragma unroll
  for (int j = 0; j < 4; ++j)
#pragma unroll
    for (int i = 0; i < 8; ++i) {
      const int kk = i * 8 + (t >> 6), n = n0 + j * 64 + (t & 63);
      v[j][i] = (n < N) ? src[(size_t)(k0 + kk) * N + n] : 0.f;
    }
  float gs[8];
#pragma unroll
  for (int i = 0; i < 8; ++i) { const int kk = i * 8 + (t >> 6); gs[i] = (mode == 2) ? g[k0 + kk] * MLA_QS : (mode == 3) ? g[k0 + kk] : 1.f; }
  __syncthreads();
#pragma unroll
  for (int j = 0; j < 4; ++j)
#pragma unroll
    for (int i = 0; i < 8; ++i) {
      const int kk = i * 8 + (t >> 6), nn = t & 63;
      float x = v[j][i] * gs[i];
      if (mode == 0 && n0 + j * 64 + nn < 512) x *= NA_QS;
      tile[j * (64 * 65) + kk * 65 + nn] = x;
    }
  __syncthreads();
#pragma unroll
  for (int j = 0; j < 4; ++j)
#pragma unroll
    for (int i = 0; i < 4; ++i) {
      const int nn = i * 16 + (t >> 5), kp = t & 31;
      const int n = n0 + j * 64 + nn;
      if (n < N) {
        const int nr = (mode == 0) ? remap_in(n) : (mode == 3 ? ((n & 64) ? 512 : 0) + (n >> 7) * 64 + (n & 63) : n);
        *reinterpret_cast<unsigned*>(dst + (size_t)nr * dstK + k0 + 2 * kp) = pack2(tile[j * (64 * 65) + (2 * kp) * 65 + nn], tile[j * (64 * 65) + (2 * kp + 1) * 65 + nn]);
      }
    }
}

DI void adaln_item(int tid, const Params& P, int l, int cc, float* sil) {
  const int t = tid, kg = t >> 5, cl = t & 31, n0 = cc * 32;
  float acc[33];
#pragma unroll
  for (int r = 0; r < 33; ++r) acc[r] = 0.f;
  const float* W = P.w_ada + (size_t)l * 1024 * 3072;
  const unsigned wlane = (unsigned)(kg * 16) * 3072u + (unsigned)(n0 + cl);
  const unsigned clane = (unsigned)(t >> 8) * 1024u + (unsigned)(t & 255);
#pragma unroll 1
  for (int kq = 0; kq < 4; ++kq) {
    float wv[16], cv[17];
#pragma unroll
    for (int j = 0; j < 16; ++j) wv[j] = (W + (size_t)(kq * 256 + j) * 3072)[wlane];
#pragma unroll
    for (int i = 0; i < 16; ++i) cv[i] = (P.c + (2 * i * 1024 + kq * 256))[clane];
    cv[16] = (P.c_ctx + kq * 256)[t & 255];
    __syncthreads();
#pragma unroll
    for (int i = 0; i < 17; ++i) { const int idx = t + i * NTHREADS; if (idx < 33 * 256) sil[idx] = silu(cv[i]); }
    __syncthreads();
#pragma unroll
    for (int r = 0; r < 33; ++r) {
      const float4* s4 = reinterpret_cast<const float4*>(sil + r * 256 + kg * 16);
#pragma unroll
      for (int q = 0; q < 4; ++q) {
        const float4 sv = s4[q];
        acc[r] += sv.x * wv[4 * q] + sv.y * wv[4 * q + 1] + sv.z * wv[4 * q + 2] + sv.w * wv[4 * q + 3];
      }
      if ((r & 3) == 3) __builtin_amdgcn_sched_barrier(0);
    }
  }
  __syncthreads();
#pragma unroll
  for (int r = 0; r < 33; ++r) sil[(kg * 33 + r) * 32 + cl] = acc[r];
  __syncthreads();
  float* MOD = reinterpret_cast<float*>(P.ws + WS_MOD) + (size_t)l * 33 * 3072;
  for (int idx = t; idx < 33 * 32; idx += NTHREADS) {
    const int r = idx >> 5, c2 = idx & 31;
    float s = 0.f;
#pragma unroll
    for (int k2 = 0; k2 < 16; ++k2) s += sil[(k2 * 33 + r) * 32 + c2];
    MOD[r * 3072 + n0 + c2] = s + P.b_ada[l * 3072 + n0 + c2];
  }
}

constexpr int P0_ADA = 2 * 96, P0_TR_IN = 16 * 12, P0_TR_OUT = 64, P0_TR_UQ = 12, P0_TR_UKV = 8;
constexpr int P0_TR_L = P0_TR_IN + P0_TR_OUT + P0_TR_UQ + P0_TR_UKV;
constexpr int P0_PAD = 4, P0_ROPE = 64;
constexpr int P0_ITEMS = P0_ADA + 2 * P0_TR_L + P0_PAD + P0_ROPE;

DI void phase0(int tid, const Params& P, char* lds, int bid, int nblk) {
  float* fl = reinterpret_cast<float*>(lds);
  const int t = tid;
  const int n_other = P0_ITEMS - P0_ADA, spare = nblk - P0_ADA;
  const int n_it = (spare <= 0) ? (P0_ITEMS - bid + nblk - 1) / nblk : (bid < P0_ADA ? 2 : (n_other - P0_ADA - (bid - P0_ADA) + spare - 1) / spare);
  for (int k = 0; k < n_it; ++k) {
    const int it = (spare <= 0) ? bid + k * nblk : (bid < P0_ADA ? (k == 0 ? bid : P0_ADA + bid) : 2 * P0_ADA + (bid - P0_ADA) + k * spare);
    if (it >= P0_ITEMS) break;
    int u = it;
    if (u < P0_ADA) { adaln_item(tid, P, u / 96, u % 96, fl); continue; }
    u -= P0_ADA;
    if (u < 2 * P0_TR_L) {
      const int l = u / P0_TR_L; int v = u % P0_TR_L;
      if (v < P0_TR_IN) {
        transpose_item(tid, P.w_in + (size_t)l * 1024 * DIN, 1024, DIN, reinterpret_cast<u16*>(P.ws + WS_WIN) + (size_t)l * 3072 * 1024, 1024, (v / 12) * 64, (v % 12) * 256, fl, 0, nullptr);
        continue;
      }
      v -= P0_TR_IN;
      if (v < P0_TR_OUT) {
        transpose_item(tid, P.w_out + (size_t)l * 1024 * 1024, 1024, 1024, reinterpret_cast<u16*>(P.ws + WS_WOUT) + (size_t)l * 1024 * 1024, 1024, (v / 4) * 64, (v % 4) * 256, fl, 1, nullptr);
        continue;
      }
      v -= P0_TR_OUT;
      if (v < P0_TR_UQ) {
        transpose_item(tid, P.w_uq + (size_t)l * 256 * 768, 256, 768, reinterpret_cast<u16*>(P.ws + WS_WUQ) + (size_t)l * 768 * 256, 256, (v / 3) * 64, (v % 3) * 256, fl, 2, P.q_norm_g + l * 256);
        continue;
      }
      v -= P0_TR_UQ;
      transpose_item(tid, P.w_ukv + (size_t)l * 128 * 1024, 128, 1024, reinterpret_cast<u16*>(P.ws + WS_WUKV) + (size_t)l * 1024 * 128, 128, (v / 4) * 64, (v % 4) * 256, fl, 3, P.kv_norm_g + l * 128);
      continue;
    }
    u -= 2 * P0_TR_L;
    if (u < 2) {
      uint4* d = reinterpret_cast<uint4*>(reinterpret_cast<u16*>(P.ws + WS_WIN) + ((size_t)u * 3072 + 672) * 1024);
      for (int i = t; i < 96 * 1024 / 8; i += NTHREADS) d[i] = make_uint4(0, 0, 0, 0);
      continue;
    }
    if (u < P0_PAD) {
      u16* d = reinterpret_cast<u16*>(P.ws + WS_WUKV) + (size_t)(u - 2) * 1024 * 256;
      (void)d;
      continue;
    }
    u -= P0_PAD;
    {
      int tr = tid; asm volatile("" : "+v"(tr));
      const int idx = u * NTHREADS + tr, pos = idx >> 4, p = idx & 15, row = pos >> 6, col = pos & 63, i = p & 7;
      const float inv = __builtin_amdgcn_exp2f(-(float)(2 * i) * (13.287712379549449f / 16.0f));
      const float ang = (float)(p < 8 ? row : col) * inv;
      float* R = reinterpret_cast<float*>(P.ws + WS_ROPE);
      R[idx] = cosf(ang);
      R[2048 * 16 + idx] = sinf(ang);
    }
  }
}

template <bool SRC_BF16>
DI void norm_load_row(const Params& P, int row, int lane, float (&v)[16]) {
  const int b = row / TPB, pos = row - b * TPB;
  if constexpr (!SRC_BF16) {
    const float* src = pos < SEQ ? P.x + ((size_t)b * SEQ + pos) * 1024 : P.ctx + ((size_t)b * CTX + (pos - SEQ)) * 1024;
#pragma unroll
    for (int q = 0; q < 2; ++q) {
      const float4 a = *reinterpret_cast<const float4*>(src + q * 512 + lane * 8);
      const float4 bq = *reinterpret_cast<const float4*>(src + q * 512 + lane * 8 + 4);
      v[q * 8 + 0] = a.x; v[q * 8 + 1] = a.y; v[q * 8 + 2] = a.z; v[q * 8 + 3] = a.w;
      v[q * 8 + 4] = bq.x; v[q * 8 + 5] = bq.y; v[q * 8 + 6] = bq.z; v[q * 8 + 7] = bq.w;
    }
  } else {
    const u16* src = pos < SEQ ? reinterpret_cast<const u16*>(P.out) + ((size_t)b * SEQ + pos) * 1024
                               : reinterpret_cast<const u16*>(P.ws + WS_CTX1) + ((size_t)b * CTX + (pos - SEQ)) * 1024;
#pragma unroll
    for (int q = 0; q < 2; ++q) {
      const uint4 a = *reinterpret_cast<const uint4*>(src + q * 512 + lane * 8);
      v[q * 8 + 0] = bflo(a.x); v[q * 8 + 1] = bfhi(a.x); v[q * 8 + 2] = bflo(a.y); v[q * 8 + 3] = bfhi(a.y);
      v[q * 8 + 4] = bflo(a.z); v[q * 8 + 5] = bfhi(a.z); v[q * 8 + 6] = bflo(a.w); v[q * 8 + 7] = bfhi(a.w);
    }
  }
}
template <bool SRC_BF16>
DI void norm_rows(int tid, const Params& P, int layer, int bid, int nblk) {
  const int t = tid, lane = t & 63, wave = __builtin_amdgcn_readfirstlane(t >> 6);
  const float* MOD = reinterpret_cast<const float*>(P.ws + WS_MOD) + (size_t)layer * 33 * 3072;
  const float* g = P.norm_g + layer * 1024;
  u16* H = reinterpret_cast<u16*>(P.ws + WS_H);
  constexpr int RPW = 36;
  for (int gw = bid * NWAVES + wave; gw * RPW < MT; gw += nblk * NWAVES) {
    const int row0 = gw * RPW;
    int mi = -1;
    float G[16], S[16], v[16], vn[16];
    norm_load_row<SRC_BF16>(P, row0, lane, v);
#pragma unroll 2
    for (int i = 0; i < RPW; ++i) {
      const int row = row0 + i;
      if (i + 1 < RPW) norm_load_row<SRC_BF16>(P, row + 1, lane, vn);
      const int b = row / TPB, pos = row - b * TPB, midx = pos < SEQ ? b : 32;
      if (midx != mi) {
        mi = midx;
        const float* md = MOD + midx * 3072;
#pragma unroll
        for (int q = 0; q < 2; ++q)
#pragma unroll
          for (int e = 0; e < 8; ++e) { const int k = q * 512 + lane * 8 + e; G[q * 8 + e] = g[k] * (1.f + md[1024 + k]); S[q * 8 + e] = md[k]; }
      }
      float ss = 0.f;
#pragma unroll
      for (int j = 0; j < 16; ++j) ss += v[j] * v[j];
      ss = wave_sum(ss);
      const float rstd = rsqrtf(ss * (1.f / 1024.f) + EPS);
#pragma unroll
      for (int q = 0; q < 2; ++q) {
        float o[8];
#pragma unroll
        for (int e = 0; e < 8; ++e) o[e] = v[q * 8 + e] * rstd * G[q * 8 + e] + S[q * 8 + e];
        uint4 w;
        w.x = pack2(o[0], o[1]); w.y = pack2(o[2], o[3]); w.z = pack2(o[4], o[5]); w.w = pack2(o[6], o[7]);
        *reinterpret_cast<uint4*>(H + (size_t)row * 1024 + q * 512 + lane * 8) = w;
      }
#pragma unroll
      for (int j = 0; j < 16; ++j) v[j] = vn[j];
    }
  }
}
DI void phase_norm(int tid, const Params& P, int layer, int bid, int nblk) {
  if (layer == 0) norm_rows<false>(tid, P, layer, bid, nblk); else norm_rows<true>(tid, P, layer, bid, nblk);
}

namespace pg8 {
#define PG8_LAS __attribute__((address_space(3)))
typedef unsigned short bf16_t;
typedef short bf16x8 __attribute__((ext_vector_type(8)));
typedef float f32x4 __attribute__((ext_vector_type(4)));
typedef unsigned u32x4 __attribute__((ext_vector_type(4)));
constexpr int BM = 256, BK = 64, HALF = 128, HTB = HALF * BK * 2  , STAGE_BYTES = 8 * HTB, NXCD = 8, WGM = 8;

__host__ __device__ __forceinline__ int lds_byte(int r, int c) { const int st = (r >> 4) * 2 + (c >> 5), rr = r & 15, cc = c & 31, ob = rr * 64 + cc * 2; return st * 1024 + (ob ^ (((ob >> 9) & 1) << 5)); }
__host__ __device__ __forceinline__ void stage_rc(int b, int& R, int& C) { const int st = b / 1024, sb = b % 1024, swz = sb ^ (((sb >> 9) & 1) << 5); R = (st >> 1) * 16 + swz / 64; C = (st & 1) * 32 + (swz % 64) / 2; }
__host__ __device__ __forceinline__ int perm32(int rho) { const int n = rho >> 4, i = rho & 15; return 8 * (i >> 2) + 4 * n + (i & 3); }


struct Unit { int pm, pn; };
struct Gemm { const bf16_t* A; const bf16_t* Bt; int M, N, K, lda; };

struct StaticOrder {
    int nM, nN, nwg, G, c;
    __host__ __device__ void init(int M, int N, int G_, int c_) { nM = M / BM; nN = N / BM; nwg = nM * nN; G = G_; c = c_; }
    __host__ __device__ bool next(int i, Unit& u) const {
        const long L = (long)i * G + c; if (L >= nwg) return false;
        int wgid = (int)L; { const int q = nwg / NXCD, r = nwg % NXCD, xcd = wgid % NXCD, off = wgid / NXCD; wgid = (xcd < r ? xcd * (q + 1) : r * (q + 1) + (xcd - r) * q) + off; }
        const int nig = WGM * nN, gid = wgid / nig, fm = gid * WGM, gsz = (nM - fm) < WGM ? (nM - fm) : WGM;
        u.pm = fm + ((wgid % nig) % gsz); u.pn = (wgid % nig) / gsz; return true;
    }
    __device__ __forceinline__ void a_ready(const Unit&) const {}
    __device__ __forceinline__ void done(const Unit&) const {}
};
struct LatentOrder : StaticOrder {
    int skipctx;
    __host__ __device__ bool next(int i, Unit& u) const { if (!StaticOrder::next(i, u)) return false; if (skipctx) u.pm += u.pm >> 3; return true; }
};

__device__ __forceinline__ float rstd_q(const unsigned char* ws, int m) {
    const f32x4 a = *(const f32x4*)(reinterpret_cast<const float*>(ws + WS_SSQ) + (size_t)m * 8);
    const f32x4 b = *(const f32x4*)(reinterpret_cast<const float*>(ws + WS_SSQ) + (size_t)m * 8 + 4);
    return rsqrtf((((a[0] + a[1]) + (a[2] + a[3])) + ((b[0] + b[1]) + (b[2] + b[3]))) * (1.f / 256.f) + EPS);
}
__device__ __forceinline__ float rstd_kv(const unsigned char* ws, int m) {
    const f32x4 a = *(const f32x4*)(reinterpret_cast<const float*>(ws + WS_SSKV) + (size_t)m * 4);
    return rsqrtf(((a[0] + a[1]) + (a[2] + a[3])) * (1.f / 128.f) + EPS);
}
__device__ __forceinline__ void store_vt8(bf16_t* vt, int b, int vc, int pos, const f32x4& v0, const f32x4& v1) {
    const int hh = vc >> 6, d = vc & 63;
    bf16_t* p = vt + (((size_t)b * 8 + hh) * 64 + d) * TPB + pos;
    const unsigned w0 = pack2(v0[0], v0[1]), w1 = pack2(v0[2], v0[3]), w2 = pack2(v1[0], v1[1]), w3 = pack2(v1[2], v1[3]);
    p[0] = (bf16_t)(w0 & 0xffffu); p[TPB] = (bf16_t)(w0 >> 16); p[2 * TPB] = (bf16_t)(w1 & 0xffffu); p[3 * TPB] = (bf16_t)(w1 >> 16);
    p[4 * TPB] = (bf16_t)(w2 & 0xffffu); p[5 * TPB] = (bf16_t)(w2 >> 16); p[6 * TPB] = (bf16_t)(w3 & 0xffffu); p[7 * TPB] = (bf16_t)(w3 >> 16);
}

struct InprojOrder : StaticOrder {
    int skip;
    __host__ __device__ bool next(int i, Unit& u) const {
        if (!skip) return StaticOrder::next(i, u);
        const long L = (long)i * G + c;
        if (L >= nwg + 160) return false;
        if (L >= nwg) { const int j = (int)(L - nwg), b = j / 5, k = j - b * 5; u.pm = 9 * b + 8; u.pn = k < 3 ? k : k + 7; return true; }
        StaticOrder::next(i, u); u.pm += u.pm >> 3; return true;
    }
};
struct NoPre {};
struct EpiInproj {
    static constexpr bool PERM = true, AFTER_DRAIN = false;
    typedef NoPre Pre;
    __device__ __forceinline__ Pre prefetch(const Unit&, int, int, int, int) const { return Pre{}; }
    unsigned char* ws;
    __device__ __forceinline__ void operator()(const f32x4 (&acc)[2][2][4][2], const Unit& u, int wr, int wc, int fr, int fq, const Pre& pre) const {
        const int row0 = u.pm * BM + wr * 64 + fr;
        const int b = u.pm / 9, posr0 = (u.pm - b * 9) * 256 + wr * 64 + fr;
#pragma unroll
        for (int bj = 0; bj < 2; ++bj) {
            const int n0 = u.pn * BM + bj * HALF, cl = wc * 32 + 8 * fq;
            if (n0 == 640) {
                if (wc == 0) {
                    const float* R = reinterpret_cast<const float*>(ws + WS_ROPE) + (cl >> 1);
#pragma unroll
                    for (int ai = 0; ai < 2; ++ai) {
                        f32x4 cs[4], sn[4];
#pragma unroll
                        for (int m = 0; m < 4; ++m) {
                            const int pc = min(posr0 + ai * HALF + m * 16, SEQ - 1);
                            cs[m] = *(const f32x4*)(R + pc * 16); sn[m] = *(const f32x4*)(R + 2048 * 16 + pc * 16);
                        }
                        __builtin_amdgcn_sched_barrier(0);
#pragma unroll
                        for (int m = 0; m < 4; ++m) {
                            const int pos = posr0 + ai * HALF + m * 16;
                            f32x4 v0 = acc[ai][bj][m][0], v1 = acc[ai][bj][m][1];
                            if (pos < SEQ) {
                                const f32x4 r0 = {v0[0] * cs[m][0] - v0[1] * sn[m][0], v0[0] * sn[m][0] + v0[1] * cs[m][0], v0[2] * cs[m][1] - v0[3] * sn[m][1], v0[2] * sn[m][1] + v0[3] * cs[m][1]};
                                const f32x4 r1 = {v1[0] * cs[m][2] - v1[1] * sn[m][2], v1[0] * sn[m][2] + v1[1] * cs[m][2], v1[2] * cs[m][3] - v1[3] * sn[m][3], v1[2] * sn[m][3] + v1[3] * cs[m][3]};
                                v0 = r0; v1 = r1;
                            }
                            uint4 w; w.x = pack2(v0[0], v0[1]); w.y = pack2(v0[2], v0[3]); w.z = pack2(v1[0], v1[1]); w.w = pack2(v1[2], v1[3]);
                            bf16_t* d = reinterpret_cast<bf16_t*>(ws + WS_KMLA) + ((size_t)b * 8 * TPB + pos) * 96 + 64 + cl;
#pragma unroll
                            for (int hh = 0; hh < 8; ++hh) *reinterpret_cast<uint4*>(d + (size_t)hh * TPB * 96) = w;
                        }
                        __builtin_amdgcn_sched_barrier(0);
                    }
                }
                continue;
            }
            if (n0 >= 2560) {
#pragma unroll
                for (int ai = 0; ai < 2; ++ai)
#pragma unroll
                    for (int m = 0; m < 4; ++m)
                        store_vt8(reinterpret_cast<bf16_t*>(ws + WS_VTNA), b, n0 - 2560 + cl, posr0 + ai * HALF + m * 16, acc[ai][bj][m][0], acc[ai][bj][m][1]);
                continue;
            }
            bf16_t* dst; int ld; bool act = false; int ssk = 0; float* ssp = nullptr;
            if (n0 < 512) { dst = reinterpret_cast<bf16_t*>(ws + WS_KNA) + n0; ld = 512; }
            else if (n0 < 640) { dst = reinterpret_cast<bf16_t*>(ws + WS_CQKV) + 256; ld = 384; ssk = 4; ssp = reinterpret_cast<float*>(ws + WS_SSKV) + wc; }
            else if (n0 < 1280) { dst = reinterpret_cast<bf16_t*>(ws + WS_QNA) + (n0 - 768); ld = 512; }
            else if (n0 < 1792) { dst = reinterpret_cast<bf16_t*>(ws + WS_GNA) + (n0 - 1280); ld = 512; act = true; }
            else if (n0 < 2048) { dst = reinterpret_cast<bf16_t*>(ws + WS_CQKV) + (n0 - 1792); ld = 384; ssk = 8; ssp = reinterpret_cast<float*>(ws + WS_SSQ) + ((n0 - 1792) >> 7) * 4 + wc; }
            else { dst = reinterpret_cast<bf16_t*>(ws + WS_GMLA) + (n0 - 2048); ld = 512; act = true; }
#pragma unroll
            for (int ai = 0; ai < 2; ++ai)
#pragma unroll
                for (int m = 0; m < 4; ++m) {
                    const int row = row0 + ai * HALF + m * 16;
                    f32x4 v0 = acc[ai][bj][m][0], v1 = acc[ai][bj][m][1];
                    if (act) {
#pragma unroll
                        for (int j = 0; j < 4; ++j) { v0[j] = silu(v0[j]); v1[j] = silu(v1[j]); }
                    }
                    uint4 w; w.x = pack2(v0[0], v0[1]); w.y = pack2(v0[2], v0[3]); w.z = pack2(v1[0], v1[1]); w.w = pack2(v1[2], v1[3]);
                    *reinterpret_cast<uint4*>(dst + (size_t)row * ld + cl) = w;
                    if (ssk) {
                        const unsigned w4[4] = {w.x, w.y, w.z, w.w};
                        float s = 0.f;
#pragma unroll
                        for (int e = 0; e < 4; ++e) { const float lo = bflo(w4[e]), hi = bfhi(w4[e]); s += lo * lo + hi * hi; }
                        s += __shfl_xor(s, 16); s += __shfl_xor(s, 32);
                        if (fq == 0) ssp[(size_t)row * ssk] = s;
                    }
                }
        }
    }
};
struct EpiQ {
    static constexpr bool PERM = true, AFTER_DRAIN = false;
    unsigned char* ws;
    typedef NoPre Pre;
    __device__ __forceinline__ Pre prefetch(const Unit&, int, int, int, int) const { return Pre{}; }
    __device__ __forceinline__ void operator()(const f32x4 (&acc)[2][2][4][2], const Unit& u, int wr, int wc, int fr, int fq, const Pre& pre) const {
        int row0 = u.pm * BM + wr * 64 + fr;
        const int b = u.pm / 9;
        int posr0 = (u.pm - b * 9) * 256 + wr * 64 + fr, cbase = u.pn * BM + wc * 32 + 8 * fq;
        asm volatile("" : "+v"(row0), "+v"(posr0), "+v"(cbase));
        const int dd0 = cbase % 96;
        const bool has = dd0 >= 32;
        const int bjr = dd0 >= 64 ? 0 : 1;
        const float* R = reinterpret_cast<const float*>(ws + WS_ROPE) + (has ? ((dd0 >= 64 ? dd0 : dd0 + 32) - 64) >> 1 : 0);
        __builtin_amdgcn_s_waitcnt(0xC07F);
        float2 sp2[4]; f32x4 cs[4], sn[4];
#define EQ_LOAD(AI_) _Pragma("unroll") for (int m = 0; m < 4; ++m) { \
            sp2[m] = *(const float2*)(reinterpret_cast<const float*>(ws + WS_SSQ) + (size_t)(row0 + (AI_) * HALF + m * 16) * 8 + 2 * fq); \
            const int pc_ = min(posr0 + (AI_) * HALF + m * 16, SEQ - 1); \
            cs[m] = *(const f32x4*)(R + pc_ * 16); sn[m] = *(const f32x4*)(R + 2048 * 16 + pc_ * 16); }
        EQ_LOAD(0)
#pragma unroll
        for (int ai = 0; ai < 2; ++ai) {
            __builtin_amdgcn_sched_barrier(0);
            uint4 w[4][2];
#pragma unroll
            for (int m = 0; m < 4; ++m) {
                const int pos = posr0 + ai * HALF + m * 16;
                float ssum = sp2[m].x + sp2[m].y;
                { auto r16 = __builtin_amdgcn_permlane16_swap(__float_as_uint(ssum), __float_as_uint(ssum), false, false); ssum = __uint_as_float(r16[0]) + __uint_as_float(r16[1]); }
                { auto r32 = __builtin_amdgcn_permlane32_swap(__float_as_uint(ssum), __float_as_uint(ssum), false, false); ssum = __uint_as_float(r32[0]) + __uint_as_float(r32[1]); }
                const float rs = rsqrtf(ssum * (1.f / 256.f) + EPS);
#pragma unroll
                for (int bj = 0; bj < 2; ++bj) {
                    f32x4 v0 = acc[ai][bj][m][0] * rs, v1 = acc[ai][bj][m][1] * rs;
                    const bool rot = has && (bj == bjr) && (pos < SEQ);
                    const f32x4 r0 = {v0[0] * cs[m][0] - v0[1] * sn[m][0], v0[0] * sn[m][0] + v0[1] * cs[m][0], v0[2] * cs[m][1] - v0[3] * sn[m][1], v0[2] * sn[m][1] + v0[3] * cs[m][1]};
                    const f32x4 r1 = {v1[0] * cs[m][2] - v1[1] * sn[m][2], v1[0] * sn[m][2] + v1[1] * cs[m][2], v1[2] * cs[m][3] - v1[3] * sn[m][3], v1[2] * sn[m][3] + v1[3] * cs[m][3]};
#pragma unroll
                    for (int j = 0; j < 4; ++j) { v0[j] = rot ? r0[j] : v0[j]; v1[j] = rot ? r1[j] : v1[j]; }
                    w[m][bj].x = pack2(v0[0], v0[1]); w[m][bj].y = pack2(v0[2], v0[3]); w[m][bj].z = pack2(v1[0], v1[1]); w[m][bj].w = pack2(v1[2], v1[3]);
                }
            }
            __builtin_amdgcn_sched_barrier(0);
            if (ai == 0) { EQ_LOAD(1) }
            __builtin_amdgcn_sched_barrier(0);
#pragma unroll
            for (int m = 0; m < 4; ++m)
#pragma unroll
                for (int bj = 0; bj < 2; ++bj)
                    *reinterpret_cast<uint4*>(reinterpret_cast<bf16_t*>(ws + WS_QMLA) + (size_t)(row0 + ai * HALF + m * 16) * 768 + cbase + bj * HALF) = w[m][bj];
        }
#undef EQ_LOAD
    }
};
struct EpiKV {
    static constexpr bool PERM = true, AFTER_DRAIN = false;
    unsigned char* ws;
    struct Pre { float sp[2][4]; };
    __device__ __forceinline__ Pre prefetch(const Unit& u, int wr, int wc, int fr, int fq) const {
        Pre p; const int row0 = u.pm * BM + wr * 64 + fr;
#pragma unroll
        for (int ai = 0; ai < 2; ++ai)
#pragma unroll
            for (int m = 0; m < 4; ++m) p.sp[ai][m] = (reinterpret_cast<const float*>(ws + WS_SSKV) + (size_t)(row0 + ai * HALF + m * 16) * 4)[fq];
        return p;
    }
    __device__ __forceinline__ void operator()(const f32x4 (&acc)[2][2][4][2], const Unit& u, int wr, int wc, int fr, int fq, const Pre& pre) const {
        int row0 = u.pm * BM + wr * 64 + fr;
        const int b = u.pm / 9;
        int posr0 = (u.pm - b * 9) * 256 + wr * 64 + fr;
        asm volatile("" : "+v"(row0), "+v"(posr0));
        float rs[2][4];
#pragma unroll
        for (int ai = 0; ai < 2; ++ai)
#pragma unroll
            for (int m = 0; m < 4; ++m) {
                float ssum = pre.sp[ai][m];
                { auto r16 = __builtin_amdgcn_permlane16_swap(__float_as_uint(ssum), __float_as_uint(ssum), false, false); ssum = __uint_as_float(r16[0]) + __uint_as_float(r16[1]); }
                { auto r32 = __builtin_amdgcn_permlane32_swap(__float_as_uint(ssum), __float_as_uint(ssum), false, false); ssum = __uint_as_float(r32[0]) + __uint_as_float(r32[1]); }
                rs[ai][m] = rsqrtf(ssum * (1.f / 128.f) + EPS);
            }
#pragma unroll
        for (int ai = 0; ai < 2; ++ai)
#pragma unroll
            for (int m = 0; m < 4; ++m) {
                const int pos = posr0 + ai * HALF + m * 16;
#pragma unroll
                for (int bj = 0; bj < 2; ++bj) {
                    const int col = u.pn * BM + bj * HALF + wc * 32 + 8 * fq;
                    const f32x4 v0 = acc[ai][bj][m][0] * rs[ai][m], v1 = acc[ai][bj][m][1] * rs[ai][m];
                    if (u.pn < 2) {
                        uint4 w; w.x = pack2(v0[0], v0[1]); w.y = pack2(v0[2], v0[3]); w.z = pack2(v1[0], v1[1]); w.w = pack2(v1[2], v1[3]);
                        *reinterpret_cast<uint4*>(reinterpret_cast<bf16_t*>(ws + WS_KMLA) + (((size_t)b * 8 + (col >> 6)) * TPB + pos) * 96 + (col & 63)) = w;
                    } else {
                        store_vt8(reinterpret_cast<bf16_t*>(ws + WS_VTMLA), b, col - 512, pos, v0, v1);
                    }
                }
            }
    }
};
struct EpiOutproj {
    static constexpr bool PERM = true, AFTER_DRAIN = false;
    typedef NoPre Pre;
    __device__ __forceinline__ Pre prefetch(const Unit&, int, int, int, int) const { return Pre{}; }
    const float* xin; const float* cin; const bf16_t* xin_b; bf16_t* xout; bf16_t* cout; const float* mod;
    __device__ __forceinline__ void operator()(const f32x4 (&acc)[2][2][4][2], const Unit& u, int wr, int wc, int fr, int fq, const Pre& pre) const {
        const int b = u.pm / 9, sub = u.pm - b * 9;
        const bool lat = sub < 8;
        const float* gate = mod + (lat ? b : 32) * 3072 + 2048;
        const size_t base = lat ? ((size_t)b * SEQ + sub * 256) * 1024 : (size_t)b * CTX * 1024;
        bf16_t* dst = (lat ? xout : cout) + base;
        int r0 = wr * 64 + fr, col0 = u.pn * BM + wc * 32 + 8 * fq;
        asm volatile("" : "+v"(r0), "+v"(col0));
        __builtin_amdgcn_s_waitcnt(0xC07F);
        f32x4 g[2][2];
#pragma unroll
        for (int bj = 0; bj < 2; ++bj) { g[bj][0] = *(const f32x4*)(gate + col0 + bj * HALF); g[bj][1] = *(const f32x4*)(gate + col0 + bj * HALF + 4); }
        if (xin_b) {
            const bf16_t* src = xin_b + base;
            uint4 xv[2][2];
#define OP_LOAD(G_) _Pragma("unroll") for (int m2 = 0; m2 < 2; ++m2) _Pragma("unroll") for (int bj = 0; bj < 2; ++bj) \
                xv[m2][bj] = *(const uint4*)(src + (size_t)(r0 + ((G_) >> 1) * HALF + (((G_) & 1) * 2 + m2) * 16) * 1024 + col0 + bj * HALF);
            OP_LOAD(0)
#pragma unroll
            for (int G = 0; G < 4; ++G) {
                __builtin_amdgcn_sched_barrier(0);
                uint4 w[2][2];
#pragma unroll
                for (int m2 = 0; m2 < 2; ++m2)
#pragma unroll
                    for (int bj = 0; bj < 2; ++bj) {
                        const int ai = G >> 1, m = (G & 1) * 2 + m2;
                        const uint4 x = xv[m2][bj];
                        const f32x4 x0 = {bflo(x.x), bfhi(x.x), bflo(x.y), bfhi(x.y)}, x1 = {bflo(x.z), bfhi(x.z), bflo(x.w), bfhi(x.w)};
                        const f32x4 y0 = x0 + g[bj][0] * acc[ai][bj][m][0], y1 = x1 + g[bj][1] * acc[ai][bj][m][1];
                        w[m2][bj].x = pack2(y0[0], y0[1]); w[m2][bj].y = pack2(y0[2], y0[3]); w[m2][bj].z = pack2(y1[0], y1[1]); w[m2][bj].w = pack2(y1[2], y1[3]);
                    }
                __builtin_amdgcn_sched_barrier(0);
                if (G < 3) { OP_LOAD(G + 1) }
                __builtin_amdgcn_sched_barrier(0);
#pragma unroll
                for (int m2 = 0; m2 < 2; ++m2)
#pragma unroll
                    for (int bj = 0; bj < 2; ++bj)
                        *(uint4*)(dst + (size_t)(r0 + (G >> 1) * HALF + ((G & 1) * 2 + m2) * 16) * 1024 + col0 + bj * HALF) = w[m2][bj];
            }
#undef OP_LOAD
        } else {
            const float* src = (lat ? xin : cin) + base;
            f32x4 xv[2][2][2];
#define OP_LOAD(G_) _Pragma("unroll") for (int m2 = 0; m2 < 2; ++m2) _Pragma("unroll") for (int bj = 0; bj < 2; ++bj) { \
                const float* sp_ = src + (size_t)(r0 + ((G_) >> 1) * HALF + (((G_) & 1) * 2 + m2) * 16) * 1024 + col0 + bj * HALF; \
                xv[m2][bj][0] = *(const f32x4*)sp_; xv[m2][bj][1] = *(const f32x4*)(sp_ + 4); }
            OP_LOAD(0)
#pragma unroll
            for (int G = 0; G < 4; ++G) {
                __builtin_amdgcn_sched_barrier(0);
                uint4 w[2][2];
#pragma unroll
                for (int m2 = 0; m2 < 2; ++m2)
#pragma unroll
                    for (int bj = 0; bj < 2; ++bj) {
                        const int ai = G >> 1, m = (G & 1) * 2 + m2;
                        const f32x4 y0 = xv[m2][bj][0] + g[bj][0] * acc[ai][bj][m][0], y1 = xv[m2][bj][1] + g[bj][1] * acc[ai][bj][m][1];
                        w[m2][bj].x = pack2(y0[0], y0[1]); w[m2][bj].y = pack2(y0[2], y0[3]); w[m2][bj].z = pack2(y1[0], y1[1]); w[m2][bj].w = pack2(y1[2], y1[3]);
                    }
                __builtin_amdgcn_sched_barrier(0);
                if (G < 3) { OP_LOAD(G + 1) }
                __builtin_amdgcn_sched_barrier(0);
#pragma unroll
                for (int m2 = 0; m2 < 2; ++m2)
#pragma unroll
                    for (int bj = 0; bj < 2; ++bj)
                        *(uint4*)(dst + (size_t)(r0 + (G >> 1) * HALF + ((G & 1) * 2 + m2) * 16) * 1024 + col0 + bj * HALF) = w[m2][bj];
            }
#undef OP_LOAD
        }
    }
};

template <class Epi, class Sched, bool STAMP = false>
__device__ __forceinline__ void gemm_phase(int tid, PG8_LAS unsigned char* lds, const Gemm g, const Sched& S, const Epi& E, unsigned long long* stamps) {
    const int wid = __builtin_amdgcn_readfirstlane(tid >> 6), lane = tid & 63, wr = wid >> 2, wc = wid & 3, fr = lane & 15, fq = lane >> 4;
    int Kv = g.K; asm volatile("" : "+s"(Kv));
    const int K = Kv, nt = K / BK;
    int ts_lo = 0, ts_hi = 0, nts = 0; const unsigned long long rt_entry = STAMP ? (unsigned long long)wall_clock64() : 0ull;
#define PG8_STAMP() do { if (STAMP && wid == 0 && nts < 64) { const unsigned long long _c = (unsigned long long)clock64(); \
        ts_lo = (lane == nts) ? (int)(unsigned)_c : ts_lo; ts_hi = (lane == nts) ? (int)(unsigned)(_c >> 32) : ts_hi; ++nts; } } while (0)
    PG8_STAMP();
    unsigned voffA[2], voffB[2];
#pragma unroll
    for (int i = 0; i < 2; ++i) { int R, C; stage_rc(tid * 16 + i * 8192, R, C); const int Rb = Epi::PERM ? ((R & ~31) + perm32(R & 31)) : R;
        voffA[i] = (unsigned)(R * g.lda + C) * 2u; voffB[i] = (unsigned)(Rb * K + C) * 2u; }
    const size_t kstep = (size_t)(BK * 2);
    const size_t hstep = (size_t)HALF * K * 2;
    const size_t tstep = 2 * hstep;
    const size_t hstepA = (size_t)HALF * g.lda * 2, tstepA = 2 * hstepA;
    const unsigned ldsw = (unsigned)wid * 1024u;
    const int aoff = lds_byte(wr * 64 + fr, fq * 8), boff = lds_byte(wc * 32 + fr, fq * 8);
#define PG8_SA(b, h) (((b) * 2 + (h)) * HTB)
#define PG8_SB(b, h) ((4 + (b) * 2 + (h)) * HTB)
#define PG8_STAGE(bufoff, gbase, voff) do { _Pragma("unroll") for (int _i = 0; _i < 2; ++_i) \
        __builtin_amdgcn_global_load_lds((const unsigned*)((const char*)(gbase) + (voff)[_i]), (PG8_LAS unsigned*)(lds + (bufoff) + ldsw + _i * 8192), 16, 0, 0); } while (0)
#define PG8_LDA(dst, b, h) do { _Pragma("unroll") for (int m = 0; m < 4; ++m) _Pragma("unroll") for (int k = 0; k < 2; ++k) dst[m][k] = *(const PG8_LAS bf16x8*)(lds + PG8_SA(b, h) + aoff + m * 2048 + k * 1024); } while (0)
#define PG8_LDB(dst, b, h) do { _Pragma("unroll") for (int n = 0; n < 2; ++n) _Pragma("unroll") for (int k = 0; k < 2; ++k) dst[n][k] = *(const PG8_LAS bf16x8*)(lds + PG8_SB(b, h) + boff + n * 2048 + k * 1024); } while (0)
#define PG8_MMA(ai, bj, At, Bt) do { __builtin_amdgcn_s_setprio(1); _Pragma("unroll") for (int m = 0; m < 4; ++m) _Pragma("unroll") for (int n = 0; n < 2; ++n) _Pragma("unroll") for (int k = 0; k < 2; ++k) \
        acc[ai][bj][m][n] = __builtin_amdgcn_mfma_f32_16x16x32_bf16(Bt[n][k], At[m][k], acc[ai][bj][m][n], 0, 0, 0); __builtin_amdgcn_s_setprio(0); } while (0)
#define PG8_WAIT_V(n) asm volatile("s_waitcnt vmcnt(" #n ")" ::: "memory")
#define PG8_WAIT_L(n) asm volatile("s_waitcnt lgkmcnt(" #n ")" ::: "memory")
#define PG8_BAR __builtin_amdgcn_s_barrier()
#define PG8_SCHED __builtin_amdgcn_sched_barrier(0)
    Unit cur, nxt; int ui = 0;
    if (!S.next(0, cur)) return;
    f32x4 acc[2][2][4][2];
#pragma unroll
    for (int a = 0; a < 2; ++a)
#pragma unroll
        for (int b = 0; b < 2; ++b)
#pragma unroll
            for (int m = 0; m < 4; ++m)
#pragma unroll
                for (int n = 0; n < 2; ++n) acc[a][b][m][n] = (f32x4){0.f, 0.f, 0.f, 0.f};
    bf16x8 At[4][2], B0[2][2], B1[2][2];
    const char* cA = (const char*)g.A + (size_t)cur.pm * tstepA; const char* cB = (const char*)g.Bt + (size_t)cur.pn * tstep;
    S.a_ready(cur);
    PG8_STAGE(PG8_SB(0, 0), cB, voffB); PG8_STAGE(PG8_SA(0, 0), cA, voffA); PG8_STAGE(PG8_SB(0, 1), cB + hstep, voffB); PG8_STAGE(PG8_SA(0, 1), cA + hstepA, voffA);
    if (wr == 1) PG8_BAR;
    PG8_WAIT_V(4); PG8_BAR;
    PG8_STAGE(PG8_SB(1, 0), cB + kstep, voffB); PG8_STAGE(PG8_SA(1, 0), cA + kstep, voffA); PG8_STAGE(PG8_SB(1, 1), cB + hstep + kstep, voffB);
    PG8_WAIT_V(6); PG8_BAR;
    PG8_STAMP();
    for (;;) {
        const bool has_next = S.next(ui + 1, nxt);
        const typename Epi::Pre pre = E.prefetch(cur, wr, wc, fr, fq);
        const char* nA = has_next ? (const char*)g.A + (size_t)nxt.pm * tstepA : cA; const char* nB = has_next ? (const char*)g.Bt + (size_t)nxt.pn * tstep : cB;
        for (int t = 0; t < nt; t += 2) {
            const bool last = (t == nt - 2);
            const char* a1 = cA + (size_t)(t + 1) * kstep;
            const char* a2 = last ? nA : cA + (size_t)(t + 2) * kstep; const char* b2 = last ? nB : cB + (size_t)(t + 2) * kstep;
            const char* a3 = a2 + kstep; const char* b3 = b2 + kstep;
            if (last && has_next) S.a_ready(nxt);
            PG8_LDB(B0, 0, 0); PG8_SCHED; PG8_LDA(At, 0, 0); PG8_STAGE(PG8_SA(1, 1), a1 + hstepA, voffA);
            PG8_WAIT_L(8); PG8_BAR; PG8_WAIT_L(0); PG8_MMA(0, 0, At, B0); PG8_BAR; PG8_SCHED;
            PG8_LDB(B1, 0, 1); PG8_STAGE(PG8_SB(0, 0), b2, voffB);
            PG8_BAR; PG8_WAIT_L(0); PG8_MMA(0, 1, At, B1); PG8_BAR;
            PG8_LDA(At, 0, 1); PG8_STAGE(PG8_SA(0, 0), a2, voffA);
            PG8_BAR; PG8_WAIT_L(0); PG8_MMA(1, 0, At, B0); PG8_BAR; PG8_SCHED;
            PG8_STAGE(PG8_SB(0, 1), b2 + hstep, voffB);
            PG8_WAIT_V(6); PG8_BAR; PG8_MMA(1, 1, At, B1); PG8_BAR;
            PG8_LDB(B0, 1, 0); PG8_SCHED; PG8_LDA(At, 1, 0); PG8_STAGE(PG8_SA(0, 1), a2 + hstepA, voffA);
            PG8_WAIT_L(8); PG8_BAR; PG8_WAIT_L(0); PG8_MMA(0, 0, At, B0); PG8_BAR; PG8_SCHED;
            PG8_LDB(B1, 1, 1); PG8_STAGE(PG8_SB(1, 0), b3, voffB);
            PG8_BAR; PG8_WAIT_L(0); PG8_MMA(0, 1, At, B1); PG8_BAR;
            PG8_LDA(At, 1, 1); PG8_STAGE(PG8_SA(1, 0), a3, voffA);
            PG8_BAR; PG8_WAIT_L(0); PG8_MMA(1, 0, At, B0); PG8_BAR; PG8_SCHED;
            PG8_STAGE(PG8_SB(1, 1), b3 + hstep, voffB);
            PG8_WAIT_V(6); PG8_BAR; PG8_MMA(1, 1, At, B1); PG8_BAR;
        }
        PG8_STAMP();
        if constexpr (!Epi::AFTER_DRAIN) { E(acc, cur, wr, wc, fr, fq, pre); S.done(cur); }
        PG8_STAMP();
        if (!has_next) break;
#pragma unroll
        for (int a = 0; a < 2; ++a)
#pragma unroll
            for (int b = 0; b < 2; ++b)
#pragma unroll
                for (int m = 0; m < 4; ++m)
#pragma unroll
                    for (int n = 0; n < 2; ++n) acc[a][b][m][n] = (f32x4){0.f, 0.f, 0.f, 0.f};
        cur = nxt; cA = nA; cB = nB; ++ui;
    }
    PG8_WAIT_V(0);
    if (wr == 0) PG8_BAR;
    PG8_BAR;
    if constexpr (Epi::AFTER_DRAIN) { E.fused(acc, cur, wr, wc, fr, fq, lds, wid, lane); S.done(cur); }
    PG8_STAMP();
    if (STAMP && wid == 0) { stamps[lane] = lane < nts ? (((unsigned long long)(unsigned)ts_hi << 32) | (unsigned)ts_lo) : 0ull;
        if (lane == 62) stamps[62] = rt_entry; if (lane == 63) stamps[63] = (unsigned long long)wall_clock64(); }
#undef PG8_STAMP
#undef PG8_SA
#undef PG8_SB
#undef PG8_STAGE
#undef PG8_LDA
#undef PG8_LDB
#undef PG8_MMA
#undef PG8_WAIT_V
#undef PG8_WAIT_L
#undef PG8_BAR
#undef PG8_SCHED
}
}

DI float vmax2(float a, float b) { float r; asm("v_max_f32 %0, %1, %2" : "=v"(r) : "v"(a), "v"(b)); return r; }
DI float xhalf_max(float x) {
  auto r = __builtin_amdgcn_permlane32_swap(__float_as_uint(x), __float_as_uint(x), false, false);
  return vmax2(__uint_as_float(r[0]), __uint_as_float(r[1]));
}

DI uint4 gated_pair(const f32x16& o, int p, float inv, uint4 gt) {
  auto x0 = __builtin_amdgcn_permlane32_swap(gt.x, gt.z, false, false);
  auto x1 = __builtin_amdgcn_permlane32_swap(gt.y, gt.w, false, false);
  const unsigned gax = x0[0], gay = x1[0], gbx = x0[1], gby = x1[1];
  const int ia = 8 * p, ib = 8 * p + 4;
  const unsigned wa0 = pack2(o[ia] * inv * bflo(gax), o[ia + 1] * inv * bfhi(gax)), wa1 = pack2(o[ia + 2] * inv * bflo(gay), o[ia + 3] * inv * bfhi(gay));
  const unsigned wb0 = pack2(o[ib] * inv * bflo(gbx), o[ib + 1] * inv * bfhi(gbx)), wb1 = pack2(o[ib + 2] * inv * bflo(gby), o[ib + 3] * inv * bfhi(gby));
  auto y0 = __builtin_amdgcn_permlane32_swap(wa0, wb0, false, false);
  auto y1 = __builtin_amdgcn_permlane32_swap(wa1, wb1, false, false);
  return make_uint4(y0[0], y1[0], y0[1], y1[1]);
}

constexpr int ATT_STAGE = 13312 + 8192;
constexpr float ATT_BIG = 1099511627776.f;
constexpr float ATT_TINY = 8.67361738e-19f;
template <int NKS, int SUBS>
DI void dense_attn_block(int tid, char* lds, const u16* __restrict__ qbase, int q_ld, const u16* __restrict__ kbase, int k_ld,
                         const u16* __restrict__ vt, int nkeys, const u16* __restrict__ gbase, int g_ld, u16* __restrict__ obase, int o_ld) {
  typedef __attribute__((address_space(3))) char lchar;
  typedef const __attribute__((address_space(3))) bf16x8* lfrag;
  constexpr int KPITCH = NKS * 32 + 16;
  constexpr int CPR = NKS * 2;
  constexpr int NKI = (64 * KPITCH) / 1024;
  lchar* L = (lchar*)lds;
  const int lane = tid & 63, wave = __builtin_amdgcn_readfirstlane(tid >> 6), l31 = lane & 31, h = lane >> 5;
  bf16x8 qf[SUBS][NKS];
#pragma unroll
  for (int sub = 0; sub < SUBS; ++sub)
#pragma unroll
    for (int s = 0; s < NKS; ++s) qf[sub][s] = as_frag(ldg16(qbase + (size_t)(wave * 32 * SUBS + sub * 32 + l31) * q_ld + 16 * s + 8 * h));
  f32x16 o[SUBS][2];
  float m[SUBS], l[SUBS];
  bool shifted[SUBS], fresh[SUBS];
#pragma unroll
  for (int sub = 0; sub < SUBS; ++sub) { shifted[sub] = false; fresh[sub] = true; }
#pragma unroll
  for (int sub = 0; sub < SUBS; ++sub) {
    m[sub] = 0.f; l[sub] = 0.f;
#pragma unroll
    for (int dt = 0; dt < 2; ++dt)
#pragma unroll
      for (int r = 0; r < 16; ++r) o[sub][dt][r] = 0.f;
  }
  unsigned koff[2], voff;
#pragma unroll
  for (int i = 0; i < 2; ++i) {
    const unsigned off = (wave + 8 * i) * 1024 + lane * 16;
    const unsigned row = off / KPITCH, c = (off - row * KPITCH) >> 4;
    koff[i] = row * k_ld + (c < (unsigned)CPR ? c : 0u) * 8;
  }
  {
    const unsigned off = wave * 1024 + lane * 16;
    const unsigned row = off >> 7, c = ((off >> 4) & 7) ^ ((row >> 1) & 7);
    voff = row * TPB + c * 8;
  }
  const unsigned ka0 = kappa(l31) * KPITCH + h * 16;
  const unsigned va0 = 13312 + l31 * 128;
  const int swz = (l31 >> 1) & 7;
  const int NT = nkeys >> 6;
#define ATT_STAGE_ISSUE(T_, BUF_) do { \
    lchar* sb_ = L + (BUF_) * ATT_STAGE + wave * 1024; \
    const u16* kb_ = kbase + (size_t)(T_) * 64 * k_ld; \
    _Pragma("unroll") for (int i_ = 0; i_ < 2; ++i_) \
      if (wave + 8 * i_ < NKI) __builtin_amdgcn_global_load_lds((const unsigned*)(kb_ + koff[i_]), (__attribute__((address_space(3))) unsigned*)(sb_ + i_ * 8192), 16, 0, 0); \
    __builtin_amdgcn_global_load_lds((const unsigned*)(vt + (T_) * 64 + voff), (__attribute__((address_space(3))) unsigned*)(sb_ + 13312), 16, 0, 0); \
  } while (0)
#define ATT_LOAD_K(DST_, BUF_, KT_) do { _Pragma("unroll") for (int ks_ = 0; ks_ < NKS; ++ks_) DST_[ks_] = *(lfrag)((BUF_) + ka0 + (KT_) * 32 * KPITCH + ks_ * 32); } while (0)
#define ATT_LOAD_V(DST_, BUF_, KT_, S2_) do { const unsigned co_ = ((2 * ((KT_) * 2 + (S2_)) + h) ^ swz) << 4; \
    DST_[0] = *(lfrag)((BUF_) + va0 + co_); DST_[1] = *(lfrag)((BUF_) + va0 + 4096 + co_); } while (0)
  __builtin_amdgcn_s_barrier();
  asm volatile("" ::: "memory");
  ATT_STAGE_ISSUE(0, 0);
  if (NT > 1) ATT_STAGE_ISSUE(1, 1);
#pragma unroll
  for (int sub = 0; sub < SUBS; ++sub)
#pragma unroll
    for (int s = 0; s < NKS; ++s) asm volatile("" :: "v"(qf[sub][s]));
  asm volatile("s_waitcnt vmcnt(0)" ::: "memory");
  __builtin_amdgcn_s_barrier();
  asm volatile("" ::: "memory");
  bf16x8 kf[NKS], vf0[2], vf1[2];
  ATT_LOAD_K(kf, L, 0);
  int stc = 0;
  for (int t = 0; t < NT; ++t) {
    const lchar* buf = L + stc * ATT_STAGE;
    const int stn = (stc == 2) ? 0 : stc + 1;
#pragma unroll
    for (int kt = 0; kt < 2; ++kt) {
      f32x16 s[SUBS];
#pragma unroll
      for (int sub = 0; sub < SUBS; ++sub)
#pragma unroll
        for (int r = 0; r < 16; ++r) s[sub][r] = 0.f;
#pragma unroll
      for (int ks = 0; ks < NKS; ++ks)
#pragma unroll
        for (int sub = 0; sub < SUBS; ++sub) s[sub] = MFMA32(kf[ks], qf[sub][ks], s[sub]);
      ATT_LOAD_V(vf0, buf, kt, 0);
      ATT_LOAD_V(vf1, buf, kt, 1);
      __builtin_amdgcn_sched_barrier(0);
      uint4 pw[SUBS][2];
#pragma unroll
      for (int sub = 0; sub < SUBS; ++sub) {
        const float mm = m[sub];
        float sum = 0.f;
        float p[16];
        if (!shifted[sub]) {
#pragma unroll
          for (int r = 0; r < 16; ++r) { p[r] = __builtin_amdgcn_exp2f(s[sub][r]); sum += p[r]; }
        } else {
#pragma unroll
          for (int r = 0; r < 16; ++r) { p[r] = __builtin_amdgcn_exp2f(s[sub][r] - mm); sum += p[r]; }
        }
        const bool was_fresh = fresh[sub];
        fresh[sub] = false;
        if (__any(!(sum <= ATT_BIG) || (was_fresh && !(sum >= ATT_TINY)))) {
          float mx = s[sub][0];
#pragma unroll
          for (int r = 1; r < 16; ++r) mx = fmaxf(mx, s[sub][r]);
          mx = xhalf_max(mx);
          const float mn = was_fresh ? mx : fmaxf(mm, mx);
          const float alpha = was_fresh ? 1.f : __builtin_amdgcn_exp2f(mm - mn);
          m[sub] = mn;
          shifted[sub] = true;
          l[sub] *= alpha;
#pragma unroll
          for (int r = 0; r < 16; ++r) { o[sub][0][r] *= alpha; o[sub][1][r] *= alpha; }
          sum = 0.f;
#pragma unroll
          for (int r = 0; r < 16; ++r) { p[r] = __builtin_amdgcn_exp2f(s[sub][r] - mn); sum += p[r]; }
        }
#pragma unroll
        for (int s2 = 0; s2 < 2; ++s2) {
          uint4 w;
          w.x = pack2(p[8 * s2], p[8 * s2 + 1]); w.y = pack2(p[8 * s2 + 2], p[8 * s2 + 3]);
          w.z = pack2(p[8 * s2 + 4], p[8 * s2 + 5]); w.w = pack2(p[8 * s2 + 6], p[8 * s2 + 7]);
          pw[sub][s2] = w;
        }
        l[sub] += sum;
      }
      __builtin_amdgcn_sched_barrier(0);
#pragma unroll
      for (int sub = 0; sub < SUBS; ++sub) {
        o[sub][0] = MFMA32(vf0[0], as_frag(pw[sub][0]), o[sub][0]);
        o[sub][1] = MFMA32(vf0[1], as_frag(pw[sub][0]), o[sub][1]);
      }
      __builtin_amdgcn_sched_barrier(0);
      if (kt == 0) {
        ATT_LOAD_K(kf, buf, 1);
      } else if (t + 1 < NT) {
        asm volatile("s_waitcnt vmcnt(0)" ::: "memory");
        __builtin_amdgcn_s_barrier();
        asm volatile("" ::: "memory");
        if (t + 2 < NT) ATT_STAGE_ISSUE(t + 2, (stn == 2) ? 0 : stn + 1);
        ATT_LOAD_K(kf, L + stn * ATT_STAGE, 0);
      }
      __builtin_amdgcn_sched_barrier(0);
#pragma unroll
      for (int sub = 0; sub < SUBS; ++sub) {
        o[sub][0] = MFMA32(vf1[0], as_frag(pw[sub][1]), o[sub][0]);
        o[sub][1] = MFMA32(vf1[1], as_frag(pw[sub][1]), o[sub][1]);
      }
    }
    stc = stn;
  }
#undef ATT_STAGE_ISSUE
#undef ATT_LOAD_K
#undef ATT_LOAD_V
#pragma unroll
  for (int sub = 0; sub < SUBS; ++sub) {
    const float lt = l[sub] + __shfl_xor(l[sub], 32);
    const float inv = 1.f / lt;
    const size_t row = (size_t)(wave * 32 * SUBS + sub * 32 + l31);
    uint4 gt[2][2];
#pragma unroll
    for (int dt = 0; dt < 2; ++dt)
#pragma unroll
      for (int p = 0; p < 2; ++p) gt[dt][p] = *reinterpret_cast<const uint4*>(gbase + row * g_ld + dt * 32 + 8 * (2 * p + h));
#pragma unroll
    for (int dt = 0; dt < 2; ++dt)
#pragma unroll
      for (int p = 0; p < 2; ++p)
        *reinterpret_cast<uint4*>(obase + row * o_ld + dt * 32 + 8 * (2 * p + h)) = gated_pair(o[sub][dt], p, inv, gt[dt][p]);
  }
}

constexpr int NA_STAGE = 32768, NA_NSTG = 3;
constexpr int NA_BIAS_OFF = NA_NSTG * NA_STAGE;
typedef __attribute__((address_space(3))) char na_lchar;
typedef const __attribute__((address_space(3))) float* na_lfp;
template <int NS, bool LOCAL>
DI void na_steps(const na_lchar* buf, const int (&ko)[NS], const na_lfp (&bp)[NS], const bf16x8 (&qf)[4], const float (&madd)[16],
                 int kap, int h, int swz, unsigned va0, f32x16& o0, f32x16& o1, float& m, float& l, bool& shifted) {
  typedef const __attribute__((address_space(3))) bf16x8* lfrag;
  bf16x8 kf[NS][4];
  float bv[NS][16];
#pragma unroll
  for (int j = 0; j < NS; ++j) {
    const int krow = ko[j] + kap;
    const na_lchar* kp_ = buf + krow * 128;
    const int ksw = (krow >> 1) & 7;
#pragma unroll
    for (int ks = 0; ks < 4; ++ks) kf[j][ks] = *(lfrag)(kp_ + (((2 * ks + h) ^ ksw) << 4));
  }
  if constexpr (LOCAL) {
#pragma unroll
    for (int j = 0; j < NS; ++j)
#pragma unroll
      for (int r = 0; r < 16; ++r) bv[j][r] = bp[j][(r & 7) + 16 * (r >> 3)];
  }
  __builtin_amdgcn_sched_barrier(0);
  f32x16 s[NS];
#pragma unroll
  for (int j = 0; j < NS; ++j)
#pragma unroll
    for (int r = 0; r < 16; ++r) s[j][r] = 0.f;
#pragma unroll
  for (int ks = 0; ks < 4; ++ks)
#pragma unroll
    for (int j = 0; j < NS; ++j) s[j] = MFMA32(kf[j][ks], qf[ks], s[j]);
  bf16x8 vv[NS][2][2];
#pragma unroll
  for (int j = 0; j < NS; ++j)
#pragma unroll
    for (int s2 = 0; s2 < 2; ++s2) {
      const unsigned co = (((ko[j] >> 3) + 2 * s2 + h) ^ swz) << 4;
      vv[j][s2][0] = *(lfrag)(buf + va0 + co);
      vv[j][s2][1] = *(lfrag)(buf + va0 + 8192 + co);
    }
  __builtin_amdgcn_sched_barrier(0);
  uint4 pw[NS][2];
#pragma unroll
  for (int j = 0; j < NS; ++j) {
    if constexpr (LOCAL) {
#pragma unroll
      for (int r = 0; r < 16; ++r) s[j][r] = fminf(s[j][r] + bv[j][r], madd[r]);
    }
    float p[16]; float sum = 0.f;
    if (!shifted) {
#pragma unroll
      for (int r = 0; r < 16; ++r) { p[r] = __builtin_amdgcn_exp2f(s[j][r]); sum += p[r]; }
    } else {
#pragma unroll
      for (int r = 0; r < 16; ++r) { p[r] = __builtin_amdgcn_exp2f(s[j][r] - m); sum += p[r]; }
    }
    if (__any(!(sum <= ATT_BIG) || (l == 0.f && !(sum >= ATT_TINY)))) {
      float mx = s[j][0];
#pragma unroll
      for (int r = 1; r < 16; ++r) mx = fmaxf(mx, s[j][r]);
      mx = xhalf_max(mx);
      const bool empty = (l == 0.f);
      const float mn = empty ? mx : fmaxf(m, mx);
      const float alpha = empty ? 1.f : __builtin_amdgcn_exp2f(m - mn);
      m = mn; shifted = true; l *= alpha;
#pragma unroll
      for (int r = 0; r < 16; ++r) { o0[r] *= alpha; o1[r] *= alpha; }
      sum = 0.f;
#pragma unroll
      for (int r = 0; r < 16; ++r) { p[r] = __builtin_amdgcn_exp2f(s[j][r] - mn); sum += p[r]; }
    }
    l += sum;
#pragma unroll
    for (int s2 = 0; s2 < 2; ++s2) {
      pw[j][s2].x = pack2(p[8 * s2], p[8 * s2 + 1]); pw[j][s2].y = pack2(p[8 * s2 + 2], p[8 * s2 + 3]);
      pw[j][s2].z = pack2(p[8 * s2 + 4], p[8 * s2 + 5]); pw[j][s2].w = pack2(p[8 * s2 + 6], p[8 * s2 + 7]);
    }
  }
  __builtin_amdgcn_sched_barrier(0);
#pragma unroll
  for (int j = 0; j < NS; ++j)
#pragma unroll
    for (int s2 = 0; s2 < 2; ++s2) {
      o0 = MFMA32(vv[j][s2][0], as_frag(pw[j][s2]), o0);
      o1 = MFMA32(vv[j][s2][1], as_frag(pw[j][s2]), o1);
    }
}

DI void na_wait_vm(int n) {
  if (n >= 12) asm volatile("s_waitcnt vmcnt(12) lgkmcnt(0)" ::: "memory");
  else if (n >= 8) asm volatile("s_waitcnt vmcnt(8) lgkmcnt(0)" ::: "memory");
  else if (n >= 4) asm volatile("s_waitcnt vmcnt(4) lgkmcnt(0)" ::: "memory");
  else asm volatile("s_waitcnt vmcnt(0) lgkmcnt(0)" ::: "memory");
}
DI void na_stream(int tid, const Params& P, char* lds, int layer, int hh, int rp2, int b0, int bstep, int nu) {
  const int lane = tid & 63, wave = __builtin_amdgcn_readfirstlane(tid >> 6), l31 = lane & 31, h = lane >> 5;
  const int rp = rp2 * 2 + (wave >> 2), j = wave & 3;
  const int qrow = 2 * rp + (l31 >> 4), qcol = 16 * j + (l31 & 15);
  const unsigned ustride = (unsigned)bstep * TPB;
  unsigned T = (unsigned)b0 * TPB + qrow * 64 + qcol;
  const u16* kbase = reinterpret_cast<const u16*>(P.ws + WS_KNA) + (size_t)b0 * TPB * 512 + hh * 64;
  const u16* vt = reinterpret_cast<const u16*>(P.ws + WS_VTNA) + ((size_t)b0 * 8 + hh) * 64 * TPB;
  const size_t kstride = (size_t)ustride * 512, vstride = (size_t)bstep * 8 * 64 * TPB;
  const u16* qbase = reinterpret_cast<const u16*>(P.ws + WS_QNA) + hh * 64;
  na_lchar* L = (na_lchar*)lds;
  __attribute__((address_space(3))) float* bias = (__attribute__((address_space(3))) float*)(L + NA_BIAS_OFF);
  const int rs_q = min(max(qrow - 4, 0), 24), qcs = min(max(qcol - 8, 0), 48);
  const int rsA = min(max(2 * rp - 4, 0), 24), rsB = min(max(2 * rp - 3, 0), 24);
  const int nrows = 8 + rsB - rsA;
  const int R0 = min(max(4 * rp2 - 4, 0), 24), R1 = min(max(4 * rp2 - 1, 0), 24) + 7;
  const int cb = (j == 0) ? 0 : (j == 1 ? 8 : (j == 2 ? 24 : 32));
  float madd[16];
#pragma unroll
  for (int r = 0; r < 16; ++r) { const int kc = cb + (r & 7) + 8 * h + 16 * (r >> 3); madd[r] = ((kc >= qcs) && (kc < qcs + 16)) ? __builtin_inff() : -1e30f; }
  unsigned koff[2], voff[2];
#pragma unroll
  for (int i = 0; i < 2; ++i) {
    const unsigned off = (wave + 8 * i) * 1024 + lane * 16;
    { const unsigned row = off >> 7, c = ((off >> 4) & 7) ^ ((row >> 1) & 7); koff[i] = row * 512 + c * 8; }
    { const unsigned d = off >> 8, c = ((off >> 4) & 15) ^ ((d >> 1) & 7); voff[i] = d * TPB + c * 8; }
  }
  const int kap = kappa(l31);
  const unsigned va0 = 16384 + l31 * 256;
  const int swz = (l31 >> 1) & 7;
  const int NT = 2 + ((R1 - R0 + 2) >> 1);
  __builtin_amdgcn_s_barrier();
  {
    int ti = tid; asm volatile("" : "+v"(ti));
    const float* rp = P.rpb + ((size_t)layer * 8 + hh) * 465;
    for (int i = ti; i < 15 * 31; i += NTHREADS) bias[i] = rp[(unsigned)i] * LOG2E;
    if (ti < 32) bias[480 + ti] = -1e30f;
  }
#define NA_TOK(T_) ((T_) < 2 ? SEQ + 128 * (T_) : (R0 + 2 * ((T_) - 2)) * 64)
#define NA_ISSUE(KB_, VT_, T_, SLOT_) do { \
    na_lchar* sb_ = L + (SLOT_) * NA_STAGE + wave * 1024; \
    const int tok_ = NA_TOK(T_); \
    _Pragma("unroll") for (int i_ = 0; i_ < 2; ++i_) \
      __builtin_amdgcn_global_load_lds((const unsigned*)((KB_) + (size_t)tok_ * 512 + koff[i_]), (__attribute__((address_space(3))) unsigned*)(sb_ + i_ * 8192), 16, 0, 0); \
    _Pragma("unroll") for (int i_ = 0; i_ < 2; ++i_) \
      __builtin_amdgcn_global_load_lds((const unsigned*)((VT_) + tok_ + voff[i_]), (__attribute__((address_space(3))) unsigned*)(sb_ + 16384 + i_ * 8192), 16, 0, 0); \
  } while (0)
  bf16x8 qf[4], qn[4];
#pragma unroll
  for (int s = 0; s < 4; ++s) qf[s] = as_frag(ldg16(qbase + (T * 512u + 16 * s + 8 * h)));
  NA_ISSUE(kbase, vt, 0, 0); NA_ISSUE(kbase, vt, 1, 1);
  asm volatile("" :: "v"(qf[0]), "v"(qf[1]), "v"(qf[2]), "v"(qf[3]));
#pragma unroll
  for (int s = 0; s < 4; ++s) qn[s] = qf[s];
  int slot_c = 0, slot_i = 2;
#pragma unroll 1
  for (int k = 0; k < nu; ++k) {
    const bool has_next = k + 1 < nu;
    f32x16 o0, o1;
#pragma unroll
    for (int r = 0; r < 16; ++r) { o0[r] = 0.f; o1[r] = 0.f; }
    float m = 0.f, l = 0.f;
    bool shifted = false;
    uint4 gg[4];
    const u16* gbase_u = reinterpret_cast<const u16*>(P.ws + WS_GNA) + hh * 64;
#pragma unroll 1
    for (int t = 0; t < NT; ++t) {
      const na_lchar* buf = L + slot_c * NA_STAGE;
      na_wait_vm((!has_next && t == NT - 1) ? 0 : (t == 0 && k > 0) ? 8 : (t == 1 && k > 0) ? 12 : 4);
      __builtin_amdgcn_s_barrier();
      asm volatile("" ::: "memory");
      if (t + 2 < NT) { NA_ISSUE(kbase, vt, t + 2, slot_i); slot_i = (slot_i == 2) ? 0 : slot_i + 1; }
      else if (has_next) { NA_ISSUE(kbase + kstride, vt + vstride, t + 2 - NT, slot_i); slot_i = (slot_i == 2) ? 0 : slot_i + 1; }
      if (t == 0) {
#pragma unroll
        for (int dt = 0; dt < 2; ++dt)
#pragma unroll
          for (int p = 0; p < 2; ++p) gg[dt * 2 + p] = *reinterpret_cast<const uint4*>(gbase_u + (T * 512u + dt * 32 + 8 * (2 * p + h)));
      }
      if (t == NT - 4 && has_next) {
#pragma unroll
        for (int s = 0; s < 4; ++s) qn[s] = as_frag(ldg16(qbase + ((T + ustride) * 512u + 16 * s + 8 * h)));
      }
      asm volatile("" ::: "memory");
      slot_c = (slot_c == 2) ? 0 : slot_c + 1;
      if (t < 2) {
#pragma unroll 1
        for (int pr = 0; pr < 4; ++pr) {
          const int ko[1] = {32 * pr};
          const na_lfp bp[1] = {bias};
          na_steps<1, false>(buf, ko, bp, qf, madd, kap, h, swz, va0, o0, o1, m, l, shifted);
        }
      } else {
        const int kr0 = R0 + 2 * (t - 2);
        const na_lfp bcol = bias + (cb - qcol + 15) + 8 * h;
#pragma unroll 1
        for (int rr = 0; rr < 2; ++rr) {
          const int kr = kr0 + rr;
          if ((kr >= rsA) && (kr < rsA + nrows)) {
            const int ko[1] = {64 * rr + cb};
            const bool ok = (kr >= rs_q) && (kr < rs_q + 8);
            const na_lfp bp[1] = {ok ? bcol + (kr - qrow + 7) * 31 : bias + 480};
            na_steps<1, true>(buf, ko, bp, qf, madd, kap, h, swz, va0, o0, o1, m, l, shifted);
          }
        }
      }
    }
#pragma unroll
    for (int s = 0; s < 4; ++s) qf[s] = qn[s];
    {
      const float lt = l + __shfl_xor(l, 32);
      const float inv = 1.f / lt;
      u16* obase_u = reinterpret_cast<u16*>(P.ws + WS_H) + hh * 64;
#pragma unroll
      for (int dt = 0; dt < 2; ++dt)
#pragma unroll
        for (int p = 0; p < 2; ++p)
          *reinterpret_cast<uint4*>(obase_u + (T * 1024u + dt * 32 + 8 * (2 * p + h))) = gated_pair(dt == 0 ? o0 : o1, p, inv, gg[dt * 2 + p]);
    }
    T += ustride; kbase += kstride; vt += vstride;
  }
#undef NA_ISSUE
#undef NA_TOK
}

constexpr int N_MLA_U = NB * 8 * 4;
constexpr int N_NA_U = NB * 8 * 8;
constexpr int N_CTX_U = NB * 8;

template <int PART>
DI void phase_attn(int tid, const Params& P, int layer, char* lds, int bid, int nblk) {
  const u16* QM = reinterpret_cast<const u16*>(P.ws + WS_QMLA);
  const u16* KM = reinterpret_cast<const u16*>(P.ws + WS_KMLA);
  const u16* VM = reinterpret_cast<const u16*>(P.ws + WS_VTMLA);
  const u16* GM = reinterpret_cast<const u16*>(P.ws + WS_GMLA);
  u16* MIX = reinterpret_cast<u16*>(P.ws + WS_H);
  const int vb = ((nblk & 7) == 0) ? (bid & 7) * (nblk >> 3) + (bid >> 3) : bid;
  const int n_main = PART == 0 ? N_NA_U : N_MLA_U;
  const int total = n_main + (layer == 0 ? N_CTX_U : 0);
  int u0 = vb;
  if constexpr (PART == 0) {
    const bool strm = (nblk & 63) == 0;
    const int nu_all = vb < n_main ? (n_main - vb + nblk - 1) / nblk : 0;
    for (int u = vb; u < n_main; u += strm ? n_main : nblk)
      na_stream(tid, P, lds, layer, (u >> 3) & 7, u & 7, u >> 6, strm ? nblk >> 6 : 0, strm ? nu_all : 1);
    u0 = vb + nu_all * nblk;
  }
  for (int u = u0; u < total; u += nblk) {
    if (u < n_main) {
      if constexpr (PART == 1) {
        const int b = u >> 5, hh = (u >> 2) & 7, qb = u & 3;
        const size_t T0 = (size_t)b * TPB + qb * 512;
        dense_attn_block<6, 2>(tid, lds, QM + T0 * 768 + hh * 96, 768, KM + ((size_t)b * 8 + hh) * TPB * 96, 96, VM + ((size_t)b * 8 + hh) * 64 * TPB, TPB,
                               GM + T0 * 512 + hh * 64, 512, MIX + T0 * 1024 + 512 + hh * 64, 1024);
      }
    } else {
      const int v = u - n_main, b = v >> 3, hh = v & 7;
      const size_t T0 = (size_t)b * TPB + SEQ;
      if constexpr (PART == 1) {
        dense_attn_block<6, 1>(tid, lds, QM + T0 * 768 + hh * 96, 768, KM + (((size_t)b * 8 + hh) * TPB + SEQ) * 96, 96, VM + ((size_t)b * 8 + hh) * 64 * TPB + SEQ, CTX,
                               GM + T0 * 512 + hh * 64, 512, MIX + T0 * 1024 + 512 + hh * 64, 1024);
      } else {
        dense_attn_block<4, 1>(tid, lds, reinterpret_cast<const u16*>(P.ws + WS_QNA) + T0 * 512 + hh * 64, 512,
                               reinterpret_cast<const u16*>(P.ws + WS_KNA) + T0 * 512 + hh * 64, 512,
                               reinterpret_cast<const u16*>(P.ws + WS_VTNA) + ((size_t)b * 8 + hh) * 64 * TPB + SEQ, CTX,
                               reinterpret_cast<const u16*>(P.ws + WS_GNA) + T0 * 512 + hh * 64, 512, MIX + T0 * 1024 + hh * 64, 1024);
      }
    }
  }
}

DI void phase_final(int tid, const Params& P, int bid, int nblk) {
  const int t = tid, lane = t & 63, wave = __builtin_amdgcn_readfirstlane(t >> 6);
  const u16* X2 = reinterpret_cast<const u16*>(P.ws + WS_X2);
  constexpr int RPW = 32;
  float4 G[4];
#pragma unroll
  for (int q = 0; q < 4; ++q) G[q] = *reinterpret_cast<const float4*>(P.final_g + q * 256 + lane * 4);
  for (int gw = bid * NWAVES + wave; gw * RPW < NB * SEQ; gw += nblk * NWAVES) {
    const int row0 = gw * RPW;
    uint2 a[4], an[4];
#pragma unroll
    for (int q = 0; q < 4; ++q) a[q] = *reinterpret_cast<const uint2*>(X2 + (size_t)row0 * 1024 + q * 256 + lane * 4);
#pragma unroll 2
    for (int i = 0; i < RPW; ++i) {
      const int row = row0 + i;
      if (i + 1 < RPW) {
#pragma unroll
        for (int q = 0; q < 4; ++q) an[q] = *reinterpret_cast<const uint2*>(X2 + (size_t)(row + 1) * 1024 + q * 256 + lane * 4);
      }
      float4 v[4];
      float ss = 0.f;
#pragma unroll
      for (int q = 0; q < 4; ++q) {
        v[q] = make_float4(bflo(a[q].x), bfhi(a[q].x), bflo(a[q].y), bfhi(a[q].y));
        ss += v[q].x * v[q].x + v[q].y * v[q].y + v[q].z * v[q].z + v[q].w * v[q].w;
      }
      ss = wave_sum(ss);
      const float rstd = rsqrtf(ss * (1.f / 1024.f) + EPS);
      float* dst = P.out + (size_t)row * 1024;
#pragma unroll
      for (int q = 0; q < 4; ++q)
        *reinterpret_cast<float4*>(dst + q * 256 + lane * 4) = make_float4(v[q].x * rstd * G[q].x, v[q].y * rstd * G[q].y, v[q].z * rstd * G[q].z, v[q].w * rstd * G[q].w);
#pragma unroll
      for (int q = 0; q < 4; ++q) a[q] = an[q];
    }
  }
}

DI void phase_inproj(int tid, const Params& P, int layer, char* lds, int bid, int nblk) {
  pg8::Gemm g{reinterpret_cast<const pg8::bf16_t*>(P.ws + WS_H), reinterpret_cast<const pg8::bf16_t*>(P.ws + WS_WIN) + (size_t)layer * 3072 * 1024, MT, NIN, 1024, 1024};
  pg8::InprojOrder S; S.init(layer == 0 ? MT : NB * SEQ, NIN, nblk, bid); S.skip = layer;
  pg8::EpiInproj E{P.ws};
  pg8::gemm_phase<pg8::EpiInproj, pg8::InprojOrder, false>(tid, (PG8_LAS unsigned char*)lds, g, S, E, nullptr);
}
DI void phase_subproj(int tid, const Params& P, int layer, char* lds, int bid, int nblk) {
  const pg8::bf16_t* A = reinterpret_cast<const pg8::bf16_t*>(P.ws + WS_CQKV);
  pg8::Gemm gq{A, reinterpret_cast<const pg8::bf16_t*>(P.ws + WS_WUQ) + (size_t)layer * 768 * 256, MT, 768, 256, 384};
  pg8::EpiQ Eq{P.ws};
  {
    pg8::LatentOrder S; S.init(layer == 0 ? MT : NB * SEQ, 768, nblk, bid); S.skipctx = layer;
    pg8::gemm_phase<pg8::EpiQ, pg8::LatentOrder, false>(tid, (PG8_LAS unsigned char*)lds, gq, S, Eq, nullptr);
  }
  pg8::Gemm gkv{A + 256, reinterpret_cast<const pg8::bf16_t*>(P.ws + WS_WUKV) + (size_t)layer * 1024 * 128, MT, 1024, 128, 384};
  pg8::EpiKV Ekv{P.ws};
  pg8::StaticOrder S2; S2.init(MT, 1024, nblk, nblk - 1 - bid);
  pg8::gemm_phase<pg8::EpiKV, pg8::StaticOrder, false>(tid, (PG8_LAS unsigned char*)lds, gkv, S2, Ekv, nullptr);
}
DI void phase_outproj(int tid, const Params& P, int layer, char* lds, int bid, int nblk) {
  pg8::Gemm g{reinterpret_cast<const pg8::bf16_t*>(P.ws + WS_H), reinterpret_cast<const pg8::bf16_t*>(P.ws + WS_WOUT) + (size_t)layer * 1024 * 1024, MT, 1024, 1024, 1024};
  pg8::EpiOutproj E{P.x, P.ctx, layer == 0 ? nullptr : reinterpret_cast<const pg8::bf16_t*>(P.out),
                    layer == 0 ? reinterpret_cast<pg8::bf16_t*>(P.out) : reinterpret_cast<pg8::bf16_t*>(P.ws + WS_X2), reinterpret_cast<pg8::bf16_t*>(P.ws + WS_CTX1),
                    reinterpret_cast<const float*>(P.ws + WS_MOD) + (size_t)layer * 33 * 3072};
  {
    pg8::LatentOrder S; S.init(layer == 0 ? MT : NB * SEQ, 1024, nblk, bid); S.skipctx = layer;
    pg8::gemm_phase<pg8::EpiOutproj, pg8::LatentOrder, false>(tid, (PG8_LAS unsigned char*)lds, g, S, E, nullptr);
  }
}

#define XB_TMO      128
#define XB_XCNT(j)  (256  + 64 * (j))
#define XB_XSUB(j)  (1280 + 64 * (j))
#define XB_XGEN(j)  (2304 + 64 * (j))
#define XB_TOP      3328
#define XB_TOPGEN   3392
#define XCD_BAR_WORDS 3456
#define XB_SPIN_CAP (1u << 22)
#define LAS __attribute__((address_space(3)))
DI unsigned xb_ld(unsigned* p)              { return __hip_atomic_load(p, __ATOMIC_RELAXED, __HIP_MEMORY_SCOPE_AGENT); }
DI unsigned xb_add(unsigned* p, unsigned v) { return __hip_atomic_fetch_add(p, v, __ATOMIC_RELAXED, __HIP_MEMORY_SCOPE_AGENT); }
DI unsigned xb_xcc_id() { return (unsigned)__builtin_amdgcn_s_getreg((3 << 11) | 20) & 0xFu; }
#define XB_SPIN(cond, bar) do { unsigned _sp = 0; while (cond) { __builtin_amdgcn_s_sleep(1); \
    if ((++_sp & 255u) == 0u) { if (xb_ld(&(bar)[XB_TMO])) break; if (_sp > XB_SPIN_CAP) { atomicAdd(&(bar)[XB_TMO], 1u); break; } } } } while (0)
struct XcdBarrier { unsigned* bar; unsigned x; volatile LAS unsigned* st; };
DI XcdBarrier xcd_barrier_post(unsigned* bar, volatile LAS unsigned* st, bool leader) {
  XcdBarrier b; b.bar = bar; b.x = xb_xcc_id(); b.st = st;
  if (leader) (void)xb_add(&bar[XB_XCNT(b.x)], 1u);
  return b;
}
DI void xcd_barrier_complete(unsigned* bar, unsigned x, unsigned& nloc, unsigned& nx) {
  const unsigned G = gridDim.x * gridDim.y * gridDim.z;
  unsigned sum, cnt, mine, sp = 0u;
  for (;;) {
    sum = 0u; cnt = 0u; mine = 0u;
#pragma unroll
    for (unsigned j = 0; j < 16; ++j) { const unsigned c = xb_ld(&bar[XB_XCNT(j)]); sum += c; cnt += (c > 0u) ? 1u : 0u; mine = (j == x) ? c : mine; }
    if (sum == G) break;
    __builtin_amdgcn_s_sleep(1);
    if ((++sp & 255u) == 0u) { if (xb_ld(&bar[XB_TMO])) break; if (sp > XB_SPIN_CAP) { atomicAdd(&bar[XB_TMO], 1u); break; } }
  }
  nloc = mine > 0u ? mine : 1u; nx = cnt > 0u ? cnt : 1u;
}
DI void xcd_barrier(const XcdBarrier& b, bool leader) {
  asm volatile("s_waitcnt vmcnt(0)" ::: "memory");
  __syncthreads();
  if (leader) {
    unsigned* bar = b.bar;
    __builtin_amdgcn_s_waitcnt(0);
    unsigned nloc = b.st[0], nx = b.st[1];
    if (nloc == 0u) { xcd_barrier_complete(bar, b.x, nloc, nx); b.st[0] = nloc; b.st[1] = nx; }
    const unsigned old = xb_add(&bar[XB_XSUB(b.x)], 1u);
    const unsigned gen = old / nloc;
    if (old + 1u == (gen + 1u) * nloc) {
      __builtin_amdgcn_fence(__ATOMIC_RELEASE, "agent");
      asm volatile("s_waitcnt vmcnt(0)" ::: "memory");
      const unsigned og = xb_add(&bar[XB_TOP], 1u);
      const unsigned tg = og / nx;
      if (og + 1u == (tg + 1u) * nx) xb_add(&bar[XB_TOPGEN], 1u);
      else XB_SPIN(xb_ld(&bar[XB_TOPGEN]) == tg, bar);
      __builtin_amdgcn_fence(__ATOMIC_ACQUIRE, "agent");
      xb_add(&bar[XB_XGEN(b.x)], 1u);
      asm volatile("s_waitcnt vmcnt(0)" ::: "memory");
    } else {
      XB_SPIN(xb_ld(&bar[XB_XGEN(b.x)]) == gen, bar);
      __builtin_amdgcn_fence(__ATOMIC_ACQUIRE, "agent");
      asm volatile("s_waitcnt vmcnt(0)" ::: "memory");
    }
  }
  __syncthreads();
}

#ifndef ONLY_K
#define ONLY_K -1
#endif
typedef const __attribute__((address_space(4))) unsigned char* kargp_t;
DI Params load_params(kargp_t kp) {
  const __attribute__((address_space(4))) unsigned long long* k8 = reinterpret_cast<const __attribute__((address_space(4))) unsigned long long*>(kp);
#define GP_(T, i) ((T*)(__attribute__((address_space(1))) T*)(k8[i]))
  Params q;
  q.x = GP_(const float, 0); q.c = GP_(const float, 1); q.ctx = GP_(const float, 2); q.c_ctx = GP_(const float, 3); q.norm_g = GP_(const float, 4);
  q.w_ada = GP_(const float, 5); q.b_ada = GP_(const float, 6); q.w_in = GP_(const float, 7); q.rpb = GP_(const float, 8); q.q_norm_g = GP_(const float, 9);
  q.w_uq = GP_(const float, 10); q.kv_norm_g = GP_(const float, 11); q.w_ukv = GP_(const float, 12); q.w_out = GP_(const float, 13); q.final_g = GP_(const float, 14);
  q.out = GP_(float, 15); q.ws = GP_(unsigned char, 16);
#undef GP_
  return q;
}
DI void run_phase(int tid, kargp_t kp, int ph, char* lds, int bid, int nblk) {
  if (ph == 0) { if (ONLY_K < 0 || ONLY_K == 5) { const Params P = load_params(kp); phase0(tid, P, lds, bid, nblk); } return; }
  if (ph == 11) { if (ONLY_K < 0 || ONLY_K == 6) { const Params P = load_params(kp); phase_final(tid, P, bid, nblk); } return; }
  const int layer = (ph - 1) / 5, k = (ph - 1) % 5;
  if (k == 0) { if (ONLY_K < 0 || ONLY_K == 0) { const Params P = load_params(kp); phase_norm(tid, P, layer, bid, nblk); } }
  else if (k == 1) { if (ONLY_K < 0 || ONLY_K == 1) { const Params P = load_params(kp); phase_inproj(tid, P, layer, lds, bid, nblk); } }
  else if (k == 2) { if (ONLY_K < 0 || ONLY_K == 2) { const Params P = load_params(kp); phase_attn<0>(tid, P, layer, lds, bid, nblk); __syncthreads(); phase_subproj(tid, P, layer, lds, bid, nblk); } }
  else if (k == 3) { if (ONLY_K < 0 || ONLY_K == 3) { const Params P = load_params(kp); phase_attn<1>(tid, P, layer, lds, bid, nblk); } }
  else { if (ONLY_K < 0 || ONLY_K == 4) { const Params P = load_params(kp); phase_outproj(tid, P, layer, lds, bid, nblk); } }
}

DI int lane_id_now() { int l; asm volatile("v_mbcnt_lo_u32_b32 %0, -1, 0\n\tv_mbcnt_hi_u32_b32 %0, -1, %0" : "=v"(l)); return l; }

#if !MK_FUSED
__global__ void __launch_bounds__(NTHREADS, 2) k_phase(Params P, int ph) {
  extern __shared__ __attribute__((aligned(16))) char lds[];
  const int tid = threadIdx.x;
  run_phase(tid, (kargp_t)__builtin_amdgcn_kernarg_segment_ptr(), ph, lds, blockIdx.x, gridDim.x);
}
#else
__global__ void __launch_bounds__(NTHREADS, 2) k_mega(Params P) {
  extern __shared__ __attribute__((aligned(16))) char lds[];
  const int wave_s = __builtin_amdgcn_readfirstlane(threadIdx.x >> 6);
#define MY_TID() (wave_s * 64 + lane_id_now())
  volatile LAS unsigned* st = (volatile LAS unsigned*)(lds + LDS_WORK);
  if (MY_TID() == 0) { st[0] = 0u; st[1] = 0u; }
  __syncthreads();
  XcdBarrier bar = xcd_barrier_post(reinterpret_cast<unsigned*>(P.ws + WS_CTL), st, MY_TID() == 0);
#pragma unroll 1
  for (int ph = 0; ph < 12; ++ph) {
    int tid = MY_TID();
    asm volatile("" : "+v"(tid));
    tid &= NTHREADS - 1;
    kargp_t kp = (kargp_t)__builtin_amdgcn_kernarg_segment_ptr();
    asm volatile("" : "+s"(kp));
    run_phase(tid, kp, ph, lds, blockIdx.x, gridDim.x);
    if (ph < 11) xcd_barrier(bar, MY_TID() == 0);
  }
#undef MY_TID
}
#endif

extern "C" void kernel_launch(void* const* d_in, const int* in_sizes, int n_in, void* d_out, int out_size, void* d_ws, size_t ws_size, hipStream_t stream) {
  static int grid_blocks = 0;
  if (!grid_blocks) {
    int dev = 0, cus = 0, per_cu = 0;
    (void)hipGetDevice(&dev);
    (void)hipDeviceGetAttribute(&cus, hipDeviceAttributeMultiprocessorCount, dev);
#if MK_FUSED
    (void)hipFuncSetAttribute((const void*)k_mega, hipFuncAttributeMaxDynamicSharedMemorySize, LDS_BYTES);
    (void)hipOccupancyMaxActiveBlocksPerMultiprocessor(&per_cu, (const void*)k_mega, NTHREADS, LDS_BYTES);
#else
    (void)hipFuncSetAttribute((const void*)k_phase, hipFuncAttributeMaxDynamicSharedMemorySize, LDS_BYTES);
    (void)hipOccupancyMaxActiveBlocksPerMultiprocessor(&per_cu, (const void*)k_phase, NTHREADS, LDS_BYTES);
#endif
    if (per_cu > 1) per_cu = 1;
    if (per_cu < 1) per_cu = 1;
    grid_blocks = cus * per_cu;
  }
  Params p{};
  p.x = (const float*)d_in[0]; p.c = (const float*)d_in[1]; p.ctx = (const float*)d_in[2]; p.c_ctx = (const float*)d_in[3];
  p.norm_g = (const float*)d_in[4]; p.w_ada = (const float*)d_in[5]; p.b_ada = (const float*)d_in[6]; p.w_in = (const float*)d_in[7];
  p.rpb = (const float*)d_in[8]; p.q_norm_g = (const float*)d_in[9]; p.w_uq = (const float*)d_in[10]; p.kv_norm_g = (const float*)d_in[11];
  p.w_ukv = (const float*)d_in[12]; p.w_out = (const float*)d_in[13]; p.final_g = (const float*)d_in[14];
  p.out = (float*)d_out; p.ws = (unsigned char*)d_ws;
#if MK_FUSED
  (void)hipMemsetAsync((char*)d_ws + WS_CTL, 0, 16384, stream);
  void* args[] = {&p};
  hipError_t e = hipLaunchCooperativeKernel((const void*)k_mega, dim3(grid_blocks), dim3(NTHREADS), args, LDS_BYTES, stream);
  if (e != hipSuccess) fprintf(stderr, "cooperative launch failed: %s (grid %d)\n", hipGetErrorString(e), grid_blocks);
#else
  for (int ph = 0; ph < 12; ++ph) hipLaunchKernelGGL(k_phase, dim3(grid_blocks), dim3(NTHREADS), LDS_BYTES, stream, p, ph);
#endif
}
```

```cpp
#include <hip/hip_runtime.h>
#include <hip/hip_cooperative_groups.h>
#include <cstdio>
namespace cg = cooperative_groups;

#ifndef MK_FUSED
#define MK_FUSED 1
#endif

#define DI __device__ __forceinline__
typedef __attribute__((ext_vector_type(8))) short bf16x8;
typedef __attribute__((ext_vector_type(16))) float f32x16;
typedef __bf16 bf16_2 __attribute__((ext_vector_type(2)));
typedef float float_2 __attribute__((ext_vector_type(2)));
typedef unsigned short u16;
#define MFMA32(a, b, c) __builtin_amdgcn_mfma_f32_32x32x16_bf16((a), (b), (c), 0, 0, 0)

constexpr int NB = 32, SEQ = 2048, CTX = 256, TPB = SEQ + CTX;
constexpr int MT = NB * TPB;
constexpr int DM = 1024, DIN = 2976;
constexpr int NIN = 3072;
constexpr float LOG2E = 1.4426950408889634f;
constexpr float NA_QS = 0.125f * LOG2E;
constexpr float MLA_QS = 0.10206207261596575f * LOG2E;
constexpr float EPS = 1e-6f;
constexpr int NTHREADS = 512, NWAVES = 8;
constexpr int LDS_WORK = 131072;
constexpr int LDS_BYTES = LDS_WORK + 512;


constexpr size_t al256(size_t x) { return (x + 255) & ~(size_t)255; }
constexpr size_t WS_CTL = 0;
constexpr size_t WS_MOD = 65536;
constexpr size_t WS_ROPE = WS_MOD + al256((size_t)2 * 33 * 3072 * 4);
constexpr size_t WS_WIN = WS_ROPE + (size_t)2 * 2048 * 16 * 4;
constexpr size_t WS_WUQ = WS_WIN + (size_t)2 * 3072 * 1024 * 2;
constexpr size_t WS_WUKV = WS_WUQ + (size_t)2 * 768 * 256 * 2;
constexpr size_t WS_WOUT = WS_WUKV + (size_t)2 * 1024 * 256 * 2;
constexpr size_t WS_H = WS_WOUT + (size_t)2 * 1024 * 1024 * 2;
constexpr size_t WS_QNA = WS_H + (size_t)MT * 1024 * 2;
constexpr size_t WS_KNA = WS_QNA + (size_t)MT * 512 * 2;
constexpr size_t WS_VTNA = WS_KNA + (size_t)MT * 512 * 2;
constexpr size_t WS_GNA = WS_VTNA + (size_t)MT * 512 * 2;
constexpr size_t WS_GMLA = WS_GNA + (size_t)MT * 512 * 2;
constexpr size_t WS_CQKV = WS_GMLA + (size_t)MT * 512 * 2;
constexpr size_t WS_QMLA = WS_CQKV + (size_t)MT * 384 * 2;
constexpr size_t WS_KMLA = WS_QMLA + (size_t)MT * 768 * 2;
constexpr size_t WS_VTMLA = WS_KMLA + (size_t)MT * 768 * 2;
constexpr size_t WS_CTX1 = WS_VTMLA + (size_t)MT * 512 * 2;
constexpr size_t WS_SSQ = WS_CTX1 + (size_t)NB * CTX * 1024 * 4;
constexpr size_t WS_SSKV = WS_SSQ + (size_t)MT * 8 * 4;
constexpr size_t WS_END = WS_SSKV + (size_t)MT * 4 * 4;
constexpr size_t WS_X2 = WS_QNA;
static_assert((size_t)NB * SEQ * 1024 * 2 <= WS_VTNA - WS_QNA, "x2 overlay");
static_assert(WS_END <= (size_t)1073741824, "workspace");

struct Params {
  const float *x, *c, *ctx, *c_ctx, *norm_g, *w_ada, *b_ada, *w_in, *rpb, *q_norm_g, *w_uq, *kv_norm_g, *w_ukv, *w_out, *final_g;
  float* out;
  unsigned char* ws;
};

DI unsigned pack2(float a, float b) { float_2 f = {a, b}; bf16_2 r = __builtin_convertvector(f, bf16_2); return __builtin_bit_cast(unsigned, r); }
DI float bflo(unsigned v) { return __uint_as_float(v << 16); }
DI float bfhi(unsigned v) { return __uint_as_float(v & 0xffff0000u); }
DI uint4 ldg16(const void* p) { return *reinterpret_cast<const uint4*>(p); }
DI bf16x8 as_frag(uint4 v) { return __builtin_bit_cast(bf16x8, v); }
DI float silu(float v) { return v * __builtin_amdgcn_rcpf(1.f + __builtin_amdgcn_exp2f(-LOG2E * v)); }
DI int kappa(int i) { return (i & 0x13) | ((i & 4) << 1) | ((i & 8) >> 1); }
DI float wave_sum(float v) {
#pragma unroll
  for (int o = 32; o >= 1; o >>= 1) v += __shfl_xor(v, o);
  return v;
}

DI int remap_in(int n) {
  return n < 512 ? 768 + n : n < 1024 ? n - 512 : n < 1536 ? 2560 + (n - 1024) : n < 2048 ? 1280 + (n - 1536) : n < 2304 ? 1792 + (n - 2048)
       : n < 2432 ? 512 + (n - 2304) : n < 2464 ? 640 + (n - 2432) : 2048 + (n - 2464);
}
DI void transpose_item(int tid, const float* __restrict__ src, int K, int N, u16* __restrict__ dst, int dstK, int k0, int n0, float* tile, int mode, const float* __restrict__ g) {
  const int t = tid;
  float v[4][8];
#pragma unroll
  for (int j = 0; j < 4; ++j)
#pragma unroll
    for (int i = 0; i < 8; ++i) {
      const int kk = i * 8 + (t >> 6), n = n0 + j * 64 + (t & 63);
      v[j][i] = (n < N) ? src[(size_t)(k0 + kk) * N + n] : 0.f;
    }
  float gs[8];
#pragma unroll
  for (int i = 0; i < 8; ++i) { const int kk = i * 8 + (t >> 6); gs[i] = (mode == 2) ? g[k0 + kk] * MLA_QS : (mode == 3) ? g[k0 + kk] : 1.f; }
  __syncthreads();
#pragma unroll
  for (int j = 0; j < 4; ++j)
#pragma unroll
    for (int i = 0; i < 8; ++i) {
      const int kk = i * 8 + (t >> 6), nn = t & 63;
      float x = v[j][i] * gs[i];
      if (mode == 0 && n0 + j * 64 + nn < 512) x *= NA_QS;
      tile[j * (64 * 65) + kk * 65 + nn] = x;
    }
  __syncthreads();
#pragma unroll
  for (int j = 0; j < 4; ++j)
#pragma unroll
    for (int i = 0; i < 4; ++i) {
      const int nn = i * 16 + (t >> 5), kp = t & 31;
      const int n = n0 + j * 64 + nn;
      if (n < N) {
        const int nr = (mode == 0) ? remap_in(n) : (mode == 3 ? ((n & 64) ? 512 : 0) + (n >> 7) * 64 + (n & 63) : n);
        *reinterpret_cast<unsigned*>(dst + (size_t)nr * dstK + k0 + 2 * kp) = pack2(tile[j * (64 * 65) + (2 * kp) * 65 + nn], tile[j * (64 * 65) + (2 * kp + 1) * 65 + nn]);
      }
    }
}

DI void adaln_item(int tid, const Params& P, int l, int cc, float* sil) {
  const int t = tid, kg = t >> 5, cl = t & 31, n0 = cc * 32;
  float acc[33];
#pragma unroll
  for (int r = 0; r < 33; ++r) acc[r] = 0.f;
  const float* W = P.w_ada + (size_t)l * 1024 * 3072;
  const unsigned wlane = (unsigned)(kg * 16) * 3072u + (unsigned)(n0 + cl);
  const unsigned clane = (unsigned)(t >> 8) * 1024u + (unsigned)(t & 255);
#pragma unroll 1
  for (int kq = 0; kq < 4; ++kq) {
    float wv[16], cv[17];
#pragma unroll
    for (int j = 0; j < 16; ++j) wv[j] = (W + (size_t)(kq * 256 + j) * 3072)[wlane];
#pragma unroll
    for (int i = 0; i < 16; ++i) cv[i] = (P.c + (2 * i * 1024 + kq * 256))[clane];
    cv[16] = (P.c_ctx + kq * 256)[t & 255];
    __syncthreads();
#pragma unroll
    for (int i = 0; i < 17; ++i) { const int idx = t + i * NTHREADS; if (idx < 33 * 256) sil[idx] = silu(cv[i]); }
    __syncthreads();
#pragma unroll
    for (int r = 0; r < 33; ++r) {
      const float4* s4 = reinterpret_cast<const float4*>(sil + r * 256 + kg * 16);
#pragma unroll
      for (int q = 0; q < 4; ++q) {
        const float4 sv = s4[q];
        acc[r] += sv.x * wv[4 * q] + sv.y * wv[4 * q + 1] + sv.z * wv[4 * q + 2] + sv.w * wv[4 * q + 3];
      }
      if ((r & 3) == 3) __builtin_amdgcn_sched_barrier(0);
    }
  }
  __syncthreads();
#pragma unroll
  for (int r = 0; r < 33; ++r) sil[(kg * 33 + r) * 32 + cl] = acc[r];
  __syncthreads();
  float* MOD = reinterpret_cast<float*>(P.ws + WS_MOD) + (size_t)l * 33 * 3072;
  for (int idx = t; idx < 33 * 32; idx += NTHREADS) {
    const int r = idx >> 5, c2 = idx & 31;
    float s = 0.f;
#pragma unroll
    for (int k2 = 0; k2 < 16; ++k2) s += sil[(k2 * 33 + r) * 32 + c2];
    MOD[r * 3072 + n0 + c2] = s + P.b_ada[l * 3072 + n0 + c2];
  }
}

constexpr int P0_ADA = 2 * 96, P0_TR_IN = 16 * 12, P0_TR_OUT = 64, P0_TR_UQ = 12, P0_TR_UKV = 8;
constexpr int P0_TR_L = P0_TR_IN + P0_TR_OUT + P0_TR_UQ + P0_TR_UKV;
constexpr int P0_PAD = 4, P0_ROPE = 64;
constexpr int P0_ITEMS = P0_ADA + 2 * P0_TR_L + P0_PAD + P0_ROPE;

DI void phase0(int tid, const Params& P, char* lds, int bid, int nblk) {
  float* fl = reinterpret_cast<float*>(lds);
  const int t = tid;
  const int n_other = P0_ITEMS - P0_ADA, spare = nblk - P0_ADA;
  const int n_it = (spare <= 0) ? (P0_ITEMS - bid + nblk - 1) / nblk : (bid < P0_ADA ? 2 : (n_other - P0_ADA - (bid - P0_ADA) + spare - 1) / spare);
  for (int k = 0; k < n_it; ++k) {
    const int it = (spare <= 0) ? bid + k * nblk : (bid < P0_ADA ? (k == 0 ? bid : P0_ADA + bid) : 2 * P0_ADA + (bid - P0_ADA) + k * spare);
    if (it >= P0_ITEMS) break;
    int u = it;
    if (u < P0_ADA) { adaln_item(tid, P, u / 96, u % 96, fl); continue; }
    u -= P0_ADA;
    if (u < 2 * P0_TR_L) {
      const int l = u / P0_TR_L; int v = u % P0_TR_L;
      if (v < P0_TR_IN) {
        transpose_item(tid, P.w_in + (size_t)l * 1024 * DIN, 1024, DIN, reinterpret_cast<u16*>(P.ws + WS_WIN) + (size_t)l * 3072 * 1024, 1024, (v / 12) * 64, (v % 12) * 256, fl, 0, nullptr);
        continue;
      }
      v -= P0_TR_IN;
      if (v < P0_TR_OUT) {
        transpose_item(tid, P.w_out + (size_t)l * 1024 * 1024, 1024, 1024, reinterpret_cast<u16*>(P.ws + WS_WOUT) + (size_t)l * 1024 * 1024, 1024, (v / 4) * 64, (v % 4) * 256, fl, 1, nullptr);
        continue;
      }
      v -= P0_TR_OUT;
      if (v < P0_TR_UQ) {
        transpose_item(tid, P.w_uq + (size_t)l * 256 * 768, 256, 768, reinterpret_cast<u16*>(P.ws + WS_WUQ) + (size_t)l * 768 * 256, 256, (v / 3) * 64, (v % 3) * 256, fl, 2, P.q_norm_g + l * 256);
        continue;
      }
      v -= P0_TR_UQ;
      transpose_item(tid, P.w_ukv + (size_t)l * 128 * 1024, 128, 1024, reinterpret_cast<u16*>(P.ws + WS_WUKV) + (size_t)l * 1024 * 128, 128, (v / 4) * 64, (v % 4) * 256, fl, 3, P.kv_norm_g + l * 128);
      continue;
    }
    u -= 2 * P0_TR_L;
    if (u < 2) {
      uint4* d = reinterpret_cast<uint4*>(reinterpret_cast<u16*>(P.ws + WS_WIN) + ((size_t)u * 3072 + 672) * 1024);
      for (int i = t; i < 96 * 1024 / 8; i += NTHREADS) d[i] = make_uint4(0, 0, 0, 0);
      continue;
    }
    if (u < P0_PAD) {
      u16* d = reinterpret_cast<u16*>(P.ws + WS_WUKV) + (size_t)(u - 2) * 1024 * 256;
      (void)d;
      continue;
    }
    u -= P0_PAD;
    {
      int tr = tid; asm volatile("" : "+v"(tr));
      const int idx = u * NTHREADS + tr, pos = idx >> 4, p = idx & 15, row = pos >> 6, col = pos & 63, i = p & 7;
      const float inv = __builtin_amdgcn_exp2f(-(float)(2 * i) * (13.287712379549449f / 16.0f));
      const float ang = (float)(p < 8 ? row : col) * inv;
      float* R = reinterpret_cast<float*>(P.ws + WS_ROPE);
      R[idx] = cosf(ang);
      R[2048 * 16 + idx] = sinf(ang);
    }
  }
}

template <bool SRC_BF16>
DI void norm_load_row(const Params& P, int row, int lane, float (&v)[16]) {
  const int b = row / TPB, pos = row - b * TPB;
  if constexpr (!SRC_BF16) {
    const float* src = pos < SEQ ? P.x + ((size_t)b * SEQ + pos) * 1024 : P.ctx + ((size_t)b * CTX + (pos - SEQ)) * 1024;
#pragma unroll
    for (int q = 0; q < 2; ++q) {
      const float4 a = *reinterpret_cast<const float4*>(src + q * 512 + lane * 8);
      const float4 bq = *reinterpret_cast<const float4*>(src + q * 512 + lane * 8 + 4);
      v[q * 8 + 0] = a.x; v[q * 8 + 1] = a.y; v[q * 8 + 2] = a.z; v[q * 8 + 3] = a.w;
      v[q * 8 + 4] = bq.x; v[q * 8 + 5] = bq.y; v[q * 8 + 6] = bq.z; v[q * 8 + 7] = bq.w;
    }
  } else {
    const u16* src = pos < SEQ ? reinterpret_cast<const u16*>(P.out) + ((size_t)b * SEQ + pos) * 1024
                               : reinterpret_cast<const u16*>(P.ws + WS_CTX1) + ((size_t)b * CTX + (pos - SEQ)) * 1024;
#pragma unroll
    for (int q = 0; q < 2; ++q) {
      const uint4 a = *reinterpret_cast<const uint4*>(src + q * 512 + lane * 8);
      v[q * 8 + 0] = bflo(a.x); v[q * 8 + 1] = bfhi(a.x); v[q * 8 + 2] = bflo(a.y); v[q * 8 + 3] = bfhi(a.y);
      v[q * 8 + 4] = bflo(a.z); v[q * 8 + 5] = bfhi(a.z); v[q * 8 + 6] = bflo(a.w); v[q * 8 + 7] = bfhi(a.w);
    }
  }
}
template <bool SRC_BF16>
DI void norm_rows(int tid, const Params& P, int layer, int bid, int nblk) {
  const int t = tid, lane = t & 63, wave = __builtin_amdgcn_readfirstlane(t >> 6);
  const float* MOD = reinterpret_cast<const float*>(P.ws + WS_MOD) + (size_t)layer * 33 * 3072;
  const float* g = P.norm_g + layer * 1024;
  u16* H = reinterpret_cast<u16*>(P.ws + WS_H);
  constexpr int RPW = 36;
  for (int gw = bid * NWAVES + wave; gw * RPW < MT; gw += nblk * NWAVES) {
    const int row0 = gw * RPW;
    int mi = -1;
    float G[16], S[16], v[16], vn[16];
    norm_load_row<SRC_BF16>(P, row0, lane, v);
#pragma unroll 2
    for (int i = 0; i < RPW; ++i) {
      const int row = row0 + i;
      if (i + 1 < RPW) norm_load_row<SRC_BF16>(P, row + 1, lane, vn);
      const int b = row / TPB, pos = row - b * TPB, midx = pos < SEQ ? b : 32;
      if (midx != mi) {
        mi = midx;
        const float* md = MOD + midx * 3072;
#pragma unroll
        for (int q = 0; q < 2; ++q)
#pragma unroll
          for (int e = 0; e < 8; ++e) { const int k = q * 512 + lane * 8 + e; G[q * 8 + e] = g[k] * (1.f + md[1024 + k]); S[q * 8 + e] = md[k]; }
      }
      float ss = 0.f;
#pragma unroll
      for (int j = 0; j < 16; ++j) ss += v[j] * v[j];
      ss = wave_sum(ss);
      const float rstd = rsqrtf(ss * (1.f / 1024.f) + EPS);
#pragma unroll
      for (int q = 0; q < 2; ++q) {
        float o[8];
#pragma unroll
        for (int e = 0; e < 8; ++e) o[e] = v[q * 8 + e] * rstd * G[q * 8 + e] + S[q * 8 + e];
        uint4 w;
        w.x = pack2(o[0], o[1]); w.y = pack2(o[2], o[3]); w.z = pack2(o[4], o[5]); w.w = pack2(o[6], o[7]);
        *reinterpret_cast<uint4*>(H + (size_t)row * 1024 + q * 512 + lane * 8) = w;
      }
#pragma unroll
      for (int j = 0; j < 16; ++j) v[j] = vn[j];
    }
  }
}
DI void phase_norm(int tid, const Params& P, int layer, int bid, int nblk) {
  if (layer == 0) norm_rows<false>(tid, P, layer, bid, nblk); else norm_rows<true>(tid, P, layer, bid, nblk);
}

namespace pg8 {
#define PG8_LAS __attribute__((address_space(3)))
typedef unsigned short bf16_t;
typedef short bf16x8 __attribute__((ext_vector_type(8)));
typedef float f32x4 __attribute__((ext_vector_type(4)));
typedef unsigned u32x4 __attribute__((ext_vector_type(4)));
constexpr int BM = 256, BK = 64, HALF = 128, HTB = HALF * BK * 2  , STAGE_BYTES = 8 * HTB, NXCD = 8, WGM = 8;

__host__ __device__ __forceinline__ int lds_byte(int r, int c) { const int st = (r >> 4) * 2 + (c >> 5), rr = r & 15, cc = c & 31, ob = rr * 64 + cc * 2; return st * 1024 + (ob ^ (((ob >> 9) & 1) << 5)); }
__host__ __device__ __forceinline__ void stage_rc(int b, int& R, int& C) { const int st = b / 1024, sb = b % 1024, swz = sb ^ (((sb >> 9) & 1) << 5); R = (st >> 1) * 16 + swz / 64; C = (st & 1) * 32 + (swz % 64) / 2; }
__host__ __device__ __forceinline__ int perm32(int rho) { const int n = rho >> 4, i = rho & 15; return 8 * (i >> 2) + 4 * n + (i & 3); }


struct Unit { int pm, pn; };
struct Gemm { const bf16_t* A; const bf16_t* Bt; int M, N, K, lda; };

struct StaticOrder {
    int nM, nN, nwg, G, c;
    __host__ __device__ void init(int M, int N, int G_, int c_) { nM = M / BM; nN = N / BM; nwg = nM * nN; G = G_; c = c_; }
    __host__ __device__ bool next(int i, Unit& u) const {
        const long L = (long)i * G + c; if (L >= nwg) return false;
        int wgid = (int)L; { const int q = nwg / NXCD, r = nwg % NXCD, xcd = wgid % NXCD, off = wgid / NXCD; wgid = (xcd < r ? xcd * (q + 1) : r * (q + 1) + (xcd - r) * q) + off; }
        const int nig = WGM * nN, gid = wgid / nig, fm = gid * WGM, gsz = (nM - fm) < WGM ? (nM - fm) : WGM;
        u.pm = fm + ((wgid % nig) % gsz); u.pn = (wgid % nig) / gsz; return true;
    }
    __device__ __forceinline__ void a_ready(const Unit&) const {}
    __device__ __forceinline__ void done(const Unit&) const {}
};
struct LatentOrder : StaticOrder {
    int skipctx;
    __host__ __device__ bool next(int i, Unit& u) const { if (!StaticOrder::next(i, u)) return false; if (skipctx) u.pm += u.pm >> 3; return true; }
};

__device__ __forceinline__ float rstd_q(const unsigned char* ws, int m) {
    const f32x4 a = *(const f32x4*)(reinterpret_cast<const float*>(ws + WS_SSQ) + (size_t)m * 8);
    const f32x4 b = *(const f32x4*)(reinterpret_cast<const float*>(ws + WS_SSQ) + (size_t)m * 8 + 4);
    return rsqrtf((((a[0] + a[1]) + (a[2] + a[3])) + ((b[0] + b[1]) + (b[2] + b[3]))) * (1.f / 256.f) + EPS);
}
__device__ __forceinline__ float rstd_kv(const unsigned char* ws, int m) {
    const f32x4 a = *(const f32x4*)(reinterpret_cast<const float*>(ws + WS_SSKV) + (size_t)m * 4);
    return rsqrtf(((a[0] + a[1]) + (a[2] + a[3])) * (1.f / 128.f) + EPS);
}
__device__ __forceinline__ void store_vt8(bf16_t* vt, int b, int vc, int pos, const f32x4& v0, const f32x4& v1) {
    const int hh = vc >> 6, d = vc & 63;
    bf16_t* p = vt + (((size_t)b * 8 + hh) * 64 + d) * TPB + pos;
    const unsigned w0 = pack2(v0[0], v0[1]), w1 = pack2(v0[2], v0[3]), w2 = pack2(v1[0], v1[1]), w3 = pack2(v1[2], v1[3]);
    p[0] = (bf16_t)(w0 & 0xffffu); p[TPB] = (bf16_t)(w0 >> 16); p[2 * TPB] = (bf16_t)(w1 & 0xffffu); p[3 * TPB] = (bf16_t)(w1 >> 16);
    p[4 * TPB] = (bf16_t)(w2 & 0xffffu); p[5 * TPB] = (bf16_t)(w2 >> 16); p[6 * TPB] = (bf16_t)(w3 & 0xffffu); p[7 * TPB] = (bf16_t)(w3 >> 16);
}

struct InprojOrder : StaticOrder {
    int skip;
    __host__ __device__ bool next(int i, Unit& u) const {
        if (!skip) return StaticOrder::next(i, u);
        const long L = (long)i * G + c;
        if (L >= nwg + 160) return false;
        if (L >= nwg) { const int j = (int)(L - nwg), b = j / 5, k = j - b * 5; u.pm = 9 * b + 8; u.pn = k < 3 ? k : k + 7; return true; }
        StaticOrder::next(i, u); u.pm += u.pm >> 3; return true;
    }
};
struct NoPre {};
struct EpiInproj {
    static constexpr bool PERM = true, AFTER_DRAIN = false;
    typedef NoPre Pre;
    __device__ __forceinline__ Pre prefetch(const Unit&, int, int, int, int) const { return Pre{}; }
    unsigned char* ws;
    __device__ __forceinline__ void operator()(const f32x4 (&acc)[2][2][4][2], const Unit& u, int wr, int wc, int fr, int fq, const Pre& pre) const {
        const int row0 = u.pm * BM + wr * 64 + fr;
        const int b = u.pm / 9, posr0 = (u.pm - b * 9) * 256 + wr * 64 + fr;
#pragma unroll
        for (int bj = 0; bj < 2; ++bj) {
            const int n0 = u.pn * BM + bj * HALF, cl = wc * 32 + 8 * fq;
            if (n0 == 640) {
                if (wc == 0) {
                    const float* R = reinterpret_cast<const float*>(ws + WS_ROPE) + (cl >> 1);
#pragma unroll
                    for (int ai = 0; ai < 2; ++ai) {
                        f32x4 cs[4], sn[4];
#pragma unroll
                        for (int m = 0; m < 4; ++m) {
                            const int pc = min(posr0 + ai * HALF + m * 16, SEQ - 1);
                            cs[m] = *(const f32x4*)(R + pc * 16); sn[m] = *(const f32x4*)(R + 2048 * 16 + pc * 16);
                        }
                        __builtin_amdgcn_sched_barrier(0);
#pragma unroll
                        for (int m = 0; m < 4; ++m) {
                            const int pos = posr0 + ai * HALF + m * 16;
                            f32x4 v0 = acc[ai][bj][m][0], v1 = acc[ai][bj][m][1];
                            if (pos < SEQ) {
                                const f32x4 r0 = {v0[0] * cs[m][0] - v0[1] * sn[m][0], v0[0] * sn[m][0] + v0[1] * cs[m][0], v0[2] * cs[m][1] - v0[3] * sn[m][1], v0[2] * sn[m][1] + v0[3] * cs[m][1]};
                                const f32x4 r1 = {v1[0] * cs[m][2] - v1[1] * sn[m][2], v1[0] * sn[m][2] + v1[1] * cs[m][2], v1[2] * cs[m][3] - v1[3] * sn[m][3], v1[2] * sn[m][3] + v1[3] * cs[m][3]};
                                v0 = r0; v1 = r1;
                            }
                            uint4 w; w.x = pack2(v0[0], v0[1]); w.y = pack2(v0[2], v0[3]); w.z = pack2(v1[0], v1[1]); w.w = pack2(v1[2], v1[3]);
                            bf16_t* d = reinterpret_cast<bf16_t*>(ws + WS_KMLA) + ((size_t)b * 8 * TPB + pos) * 96 + 64 + cl;
#pragma unroll
                            for (int hh = 0; hh < 8; ++hh) *reinterpret_cast<uint4*>(d + (size_t)hh * TPB * 96) = w;
                        }
                        __builtin_amdgcn_sched_barrier(0);
                    }
                }
                continue;
            }
            if (n0 >= 2560) {
#pragma unroll
                for (int ai = 0; ai < 2; ++ai)
#pragma unroll
                    for (int m = 0; m < 4; ++m)
                        store_vt8(reinterpret_cast<bf16_t*>(ws + WS_VTNA), b, n0 - 2560 + cl, posr0 + ai * HALF + m * 16, acc[ai][bj][m][0], acc[ai][bj][m][1]);
                continue;
            }
            bf16_t* dst; int ld; bool act = false; int ssk = 0; float* ssp = nullptr;
            if (n0 < 512) { dst = reinterpret_cast<bf16_t*>(ws + WS_KNA) + n0; ld = 512; }
            else if (n0 < 640) { dst = reinterpret_cast<bf16_t*>(ws + WS_CQKV) + 256; ld = 384; ssk = 4; ssp = reinterpret_cast<float*>(ws + WS_SSKV) + wc; }
            else if (n0 < 1280) { dst = reinterpret_cast<bf16_t*>(ws + WS_QNA) + (n0 - 768); ld = 512; }
            else if (n0 < 1792) { dst = reinterpret_cast<bf16_t*>(ws + WS_GNA) + (n0 - 1280); ld = 512; act = true; }
            else if (n0 < 2048) { dst = reinterpret_cast<bf16_t*>(ws + WS_CQKV) + (n0 - 1792); ld = 384; ssk = 8; ssp = reinterpret_cast<float*>(ws + WS_SSQ) + ((n0 - 1792) >> 7) * 4 + wc; }
            else { dst = reinterpret_cast<bf16_t*>(ws + WS_GMLA) + (n0 - 2048); ld = 512; act = true; }
#pragma unroll
            for (int ai = 0; ai < 2; ++ai)
#pragma unroll
                for (int m = 0; m < 4; ++m) {
                    const int row = row0 + ai * HALF + m * 16;
                    f32x4 v0 = acc[ai][bj][m][0], v1 = acc[ai][bj][m][1];
                    if (act) {
#pragma unroll
                        for (int j = 0; j < 4; ++j) { v0[j] = silu(v0[j]); v1[j] = silu(v1[j]); }
                    }
                    uint4 w; w.x = pack2(v0[0], v0[1]); w.y = pack2(v0[2], v0[3]); w.z = pack2(v1[0], v1[1]); w.w = pack2(v1[2], v1[3]);
                    *reinterpret_cast<uint4*>(dst + (size_t)row * ld + cl) = w;
                    if (ssk) {
                        const unsigned w4[4] = {w.x, w.y, w.z, w.w};
                        float s = 0.f;
#pragma unroll
                        for (int e = 0; e < 4; ++e) { const float lo = bflo(w4[e]), hi = bfhi(w4[e]); s += lo * lo + hi * hi; }
                        s += __shfl_xor(s, 16); s += __shfl_xor(s, 32);
                        if (fq == 0) ssp[(size_t)row * ssk] = s;
                    }
                }
        }
    }
};
struct EpiQ {
    static constexpr bool PERM = true, AFTER_DRAIN = false;
    unsigned char* ws;
    typedef NoPre Pre;
    __device__ __forceinline__ Pre prefetch(const Unit&, int, int, int, int) const { return Pre{}; }
    __device__ __forceinline__ void operator()(const f32x4 (&acc)[2][2][4][2], const Unit& u, int wr, int wc, int fr, int fq, const Pre& pre) const {
        int row0 = u.pm * BM + wr * 64 + fr;
        const int b = u.pm / 9;
        int posr0 = (u.pm - b * 9) * 256 + wr * 64 + fr, cbase = u.pn * BM + wc * 32 + 8 * fq;
        asm volatile("" : "+v"(row0), "+v"(posr0), "+v"(cbase));
        const int dd0 = cbase % 96;
        const bool has = dd0 >= 32;
        const int bjr = dd0 >= 64 ? 0 : 1;
        const float* R = reinterpret_cast<const float*>(ws + WS_ROPE) + (has ? ((dd0 >= 64 ? dd0 : dd0 + 32) - 64) >> 1 : 0);
        __builtin_amdgcn_s_waitcnt(0xC07F);
        float2 sp2[4]; f32x4 cs[4], sn[4];
#define EQ_LOAD(AI_) _Pragma("unroll") for (int m = 0; m < 4; ++m) { \
            sp2[m] = *(const float2*)(reinterpret_cast<const float*>(ws + WS_SSQ) + (size_t)(row0 + (AI_) * HALF + m * 16) * 8 + 2 * fq); \
            const int pc_ = min(posr0 + (AI_) * HALF + m * 16, SEQ - 1); \
            cs[m] = *(const f32x4*)(R + pc_ * 16); sn[m] = *(const f32x4*)(R + 2048 * 16 + pc_ * 16); }
        EQ_LOAD(0)
#pragma unroll
        for (int ai = 0; ai < 2; ++ai) {
            __builtin_amdgcn_sched_barrier(0);
            uint4 w[4][2];
#pragma unroll
            for (int m = 0; m < 4; ++m) {
                const int pos = posr0 + ai * HALF + m * 16;
                float ssum = sp2[m].x + sp2[m].y;
                { auto r16 = __builtin_amdgcn_permlane16_swap(__float_as_uint(ssum), __float_as_uint(ssum), false, false); ssum = __uint_as_float(r16[0]) + __uint_as_float(r16[1]); }
                { auto r32 = __builtin_amdgcn_permlane32_swap(__float_as_uint(ssum), __float_as_uint(ssum), false, false); ssum = __uint_as_float(r32[0]) + __uint_as_float(r32[1]); }
                const float rs = rsqrtf(ssum * (1.f / 256.f) + EPS);
#pragma unroll
                for (int bj = 0; bj < 2; ++bj) {
                    f32x4 v0 = acc[ai][bj][m][0] * rs, v1 = acc[ai][bj][m][1] * rs;
                    const bool rot = has && (bj == bjr) && (pos < SEQ);
                    const f32x4 r0 = {v0[0] * cs[m][0] - v0[1] * sn[m][0], v0[0] * sn[m][0] + v0[1] * cs[m][0], v0[2] * cs[m][1] - v0[3] * sn[m][1], v0[2] * sn[m][1] + v0[3] * cs[m][1]};
                    const f32x4 r1 = {v1[0] * cs[m][2] - v1[1] * sn[m][2], v1[0] * sn[m][2] + v1[1] * cs[m][2], v1[2] * cs[m][3] - v1[3] * sn[m][3], v1[2] * sn[m][3] + v1[3] * cs[m][3]};
#pragma unroll
                    for (int j = 0; j < 4; ++j) { v0[j] = rot ? r0[j] : v0[j]; v1[j] = rot ? r1[j] : v1[j]; }
                    w[m][bj].x = pack2(v0[0], v0[1]); w[m][bj].y = pack2(v0[2], v0[3]); w[m][bj].z = pack2(v1[0], v1[1]); w[m][bj].w = pack2(v1[2], v1[3]);
                }
            }
            __builtin_amdgcn_sched_barrier(0);
            if (ai == 0) { EQ_LOAD(1) }
            __builtin_amdgcn_sched_barrier(0);
#pragma unroll
            for (int m = 0; m < 4; ++m)
#pragma unroll
                for (int bj = 0; bj < 2; ++bj)
                    *reinterpret_cast<uint4*>(reinterpret_cast<bf16_t*>(ws + WS_QMLA) + (size_t)(row0 + ai * HALF + m * 16) * 768 + cbase + bj * HALF) = w[m][bj];
        }
#undef EQ_LOAD
    }
};
struct EpiKV {
    static constexpr bool PERM = true, AFTER_DRAIN = false;
    unsigned char* ws;
    struct Pre { float sp[2][4]; };
    __device__ __forceinline__ Pre prefetch(const Unit& u, int wr, int wc, int fr, int fq) const {
        Pre p; const int row0 = u.pm * BM + wr * 64 + fr;
#pragma unroll
        for (int ai = 0; ai < 2; ++ai)
#pragma unroll
            for (int m = 0; m < 4; ++m) p.sp[ai][m] = (reinterpret_cast<const float*>(ws + WS_SSKV) + (size_t)(row0 + ai * HALF + m * 16) * 4)[fq];
        return p;
    }
    __device__ __forceinline__ void operator()(const f32x4 (&acc)[2][2][4][2], const Unit& u, int wr, int wc, int fr, int fq, const Pre& pre) const {
        int row0 = u.pm * BM + wr * 64 + fr;
        const int b = u.pm / 9;
        int posr0 = (u.pm - b * 9) * 256 + wr * 64 + fr;
        asm volatile("" : "+v"(row0), "+v"(posr0));
        float rs[2][4];
#pragma unroll
        for (int ai = 0; ai < 2; ++ai)
#pragma unroll
            for (int m = 0; m < 4; ++m) {
                float ssum = pre.sp[ai][m];
                { auto r16 = __builtin_amdgcn_permlane16_swap(__float_as_uint(ssum), __float_as_uint(ssum), false, false); ssum = __uint_as_float(r16[0]) + __uint_as_float(r16[1]); }
                { auto r32 = __builtin_amdgcn_permlane32_swap(__float_as_uint(ssum), __float_as_uint(ssum), false, false); ssum = __uint_as_float(r32[0]) + __uint_as_float(r32[1]); }
                rs[ai][m] = rsqrtf(ssum * (1.f / 128.f) + EPS);
            }
#pragma unroll
        for (int ai = 0; ai < 2; ++ai)
#pragma unroll
            for (int m = 0; m < 4; ++m) {
                const int pos = posr0 + ai * HALF + m * 16;
#pragma unroll
                for (int bj = 0; bj < 2; ++bj) {
                    const int col = u.pn * BM + bj * HALF + wc * 32 + 8 * fq;
                    const f32x4 v0 = acc[ai][bj][m][0] * rs[ai][m], v1 = acc[ai][bj][m][1] * rs[ai][m];
                    if (u.pn < 2) {
                        uint4 w; w.x = pack2(v0[0], v0[1]); w.y = pack2(v0[2], v0[3]); w.z = pack2(v1[0], v1[1]); w.w = pack2(v1[2], v1[3]);
                        *reinterpret_cast<uint4*>(reinterpret_cast<bf16_t*>(ws + WS_KMLA) + (((size_t)b * 8 + (col >> 6)) * TPB + pos) * 96 + (col & 63)) = w;
                    } else {
                        store_vt8(reinterpret_cast<bf16_t*>(ws + WS_VTMLA), b, col - 512, pos, v0, v1);
                    }
                }
            }
    }
};
struct EpiOutproj {
    static constexpr bool PERM = true, AFTER_DRAIN = false;
    typedef NoPre Pre;
    __device__ __forceinline__ Pre prefetch(const Unit&, int, int, int, int) const { return Pre{}; }
    const float* xin; const float* cin; const bf16_t* xin_b; bf16_t* xout; bf16_t* cout; const float* mod;
    __device__ __forceinline__ void operator()(const f32x4 (&acc)[2][2][4][2], const Unit& u, int wr, int wc, int fr, int fq, const Pre& pre) const {
        const int b = u.pm / 9, sub = u.pm - b * 9;
        const bool lat = sub < 8;
        const float* gate = mod + (lat ? b : 32) * 3072 + 2048;
        const size_t base = lat ? ((size_t)b * SEQ + sub * 256) * 1024 : (size_t)b * CTX * 1024;
        bf16_t* dst = (lat ? xout : cout) + base;
        int r0 = wr * 64 + fr, col0 = u.pn * BM + wc * 32 + 8 * fq;
        asm volatile("" : "+v"(r0), "+v"(col0));
        __builtin_amdgcn_s_waitcnt(0xC07F);
        f32x4 g[2][2];
#pragma unroll
        for (int bj = 0; bj < 2; ++bj) { g[bj][0] = *(const f32x4*)(gate + col0 + bj * HALF); g[bj][1] = *(const f32x4*)(gate + col0 + bj * HALF + 4); }
        if (xin_b) {
            const bf16_t* src = xin_b + base;
            uint4 xv[2][2];
#define OP_LOAD(G_) _Pragma("unroll") for (int m2 = 0; m2 < 2; ++m2) _Pragma("unroll") for (int bj = 0; bj < 2; ++bj) \
                xv[m2][bj] = *(const uint4*)(src + (size_t)(r0 + ((G_) >> 1) * HALF + (((G_) & 1) * 2 + m2) * 16) * 1024 + col0 + bj * HALF);
            OP_LOAD(0)
#pragma unroll
            for (int G = 0; G < 4; ++G) {
                __builtin_amdgcn_sched_barrier(0);
                uint4 w[2][2];
#pragma unroll
                for (int m2 = 0; m2 < 2; ++m2)
#pragma unroll
                    for (int bj = 0; bj < 2; ++bj) {
                        const int ai = G >> 1, m = (G & 1) * 2 + m2;
                        const uint4 x = xv[m2][bj];
                        const f32x4 x0 = {bflo(x.x), bfhi(x.x), bflo(x.y), bfhi(x.y)}, x1 = {bflo(x.z), bfhi(x.z), bflo(x.w), bfhi(x.w)};
                        const f32x4 y0 = x0 + g[bj][0] * acc[ai][bj][m][0], y1 = x1 + g[bj][1] * acc[ai][bj][m][1];
                        w[m2][bj].x = pack2(y0[0], y0[1]); w[m2][bj].y = pack2(y0[2], y0[3]); w[m2][bj].z = pack2(y1[0], y1[1]); w[m2][bj].w = pack2(y1[2], y1[3]);
                    }
                __builtin_amdgcn_sched_barrier(0);
                if (G < 3) { OP_LOAD(G + 1) }
                __builtin_amdgcn_sched_barrier(0);
#pragma unroll
                for (int m2 = 0; m2 < 2; ++m2)
#pragma unroll
                    for (int bj = 0; bj < 2; ++bj)
                        *(uint4*)(dst + (size_t)(r0 + (G >> 1) * HALF + ((G & 1) * 2 + m2) * 16) * 1024 + col0 + bj * HALF) = w[m2][bj];
            }
#undef OP_LOAD
        } else {
            const float* src = (lat ? xin : cin) + base;
            f32x4 xv[2][2][2];
#define OP_LOAD(G_) _Pragma("unroll") for (int m2 = 0; m2 < 2; ++m2) _Pragma("unroll") for (int bj = 0; bj < 2; ++bj) { \
                const float* sp_ = src + (size_t)(r0 + ((G_) >> 1) * HALF + (((G_) & 1) * 2 + m2) * 16) * 1024 + col0 + bj * HALF; \
                xv[m2][bj][0] = *(const f32x4*)sp_; xv[m2][bj][1] = *(const f32x4*)(sp_ + 4); }
            OP_LOAD(0)
#pragma unroll
            for (int G = 0; G < 4; ++G) {
                __builtin_amdgcn_sched_barrier(0);
                uint4 w[2][2];
#pragma unroll
                for (int m2 = 0; m2 < 2; ++m2)
#pragma unroll
                    for (int bj = 0; bj < 2; ++bj) {
                        const int ai = G >> 1, m = (G & 1) * 2 + m2;
                        const f32x4 y0 = xv[m2][bj][0] + g[bj][0] * acc[ai][bj][m][0], y1 = xv[m2][bj][1] + g[bj][1] * acc[ai][bj][m][1];
                        w[m2][bj].x = pack2(y0[0], y0[1]); w[m2][bj].y = pack2(y0[2], y0[3]); w[m2][bj].z = pack2(y1[0], y1[1]); w[m2][bj].w = pack2(y1[2], y1[3]);
                    }
                __builtin_amdgcn_sched_barrier(0);
                if (G < 3) { OP_LOAD(G + 1) }
                __builtin_amdgcn_sched_barrier(0);
#pragma unroll
                for (int m2 = 0; m2 < 2; ++m2)
#pragma unroll
                    for (int bj = 0; bj < 2; ++bj)
                        *(uint4*)(dst + (size_t)(r0 + (G >> 1) * HALF + ((G & 1) * 2 + m2) * 16) * 1024 + col0 + bj * HALF) = w[m2][bj];
            }
#undef OP_LOAD
        }
    }
};

template <class Epi, class Sched, bool STAMP = false>
__device__ __forceinline__ void gemm_phase(int tid, PG8_LAS unsigned char* lds, const Gemm g, const Sched& S, const Epi& E, unsigned long long* stamps) {
    const int wid = __builtin_amdgcn_readfirstlane(tid >> 6), lane = tid & 63, wr = wid >> 2, wc = wid & 3, fr = lane & 15, fq = lane >> 4;
    int Kv = g.K; asm volatile("" : "+s"(Kv));
    const int K = Kv, nt = K / BK;
    int ts_lo = 0, ts_hi = 0, nts = 0; const unsigned long long rt_entry = STAMP ? (unsigned long long)wall_clock64() : 0ull;
#define PG8_STAMP() do { if (STAMP && wid == 0 && nts < 64) { const unsigned long long _c = (unsigned long long)clock64(); \
        ts_lo = (lane == nts) ? (int)(unsigned)_c : ts_lo; ts_hi = (lane == nts) ? (int)(unsigned)(_c >> 32) : ts_hi; ++nts; } } while (0)
    PG8_STAMP();
    unsigned voffA[2], voffB[2];
#pragma unroll
    for (int i = 0; i < 2; ++i) { int R, C; stage_rc(tid * 16 + i * 8192, R, C); const int Rb = Epi::PERM ? ((R & ~31) + perm32(R & 31)) : R;
        voffA[i] = (unsigned)(R * g.lda + C) * 2u; voffB[i] = (unsigned)(Rb * K + C) * 2u; }
    const size_t kstep = (size_t)(BK * 2);
    const size_t hstep = (size_t)HALF * K * 2;
    const size_t tstep = 2 * hstep;
    const size_t hstepA = (size_t)HALF * g.lda * 2, tstepA = 2 * hstepA;
    const unsigned ldsw = (unsigned)wid * 1024u;
    const int aoff = lds_byte(wr * 64 + fr, fq * 8), boff = lds_byte(wc * 32 + fr, fq * 8);
#define PG8_SA(b, h) (((b) * 2 + (h)) * HTB)
#define PG8_SB(b, h) ((4 + (b) * 2 + (h)) * HTB)
#define PG8_STAGE(bufoff, gbase, voff) do { _Pragma("unroll") for (int _i = 0; _i < 2; ++_i) \
        __builtin_amdgcn_global_load_lds((const unsigned*)((const char*)(gbase) + (voff)[_i]), (PG8_LAS unsigned*)(lds + (bufoff) + ldsw + _i * 8192), 16, 0, 0); } while (0)
#define PG8_LDA(dst, b, h) do { _Pragma("unroll") for (int m = 0; m < 4; ++m) _Pragma("unroll") for (int k = 0; k < 2; ++k) dst[m][k] = *(const PG8_LAS bf16x8*)(lds + PG8_SA(b, h) + aoff + m * 2048 + k * 1024); } while (0)
#define PG8_LDB(dst, b, h) do { _Pragma("unroll") for (int n = 0; n < 2; ++n) _Pragma("unroll") for (int k = 0; k < 2; ++k) dst[n][k] = *(const PG8_LAS bf16x8*)(lds + PG8_SB(b, h) + boff + n * 2048 + k * 1024); } while (0)
#define PG8_MMA(ai, bj, At, Bt) do { __builtin_amdgcn_s_setprio(1); _Pragma("unroll") for (int m = 0; m < 4; ++m) _Pragma("unroll") for (int n = 0; n < 2; ++n) _Pragma("unroll") for (int k = 0; k < 2; ++k) \
        acc[ai][bj][m][n] = __builtin_amdgcn_mfma_f32_16x16x32_bf16(Bt[n][k], At[m][k], acc[ai][bj][m][n], 0, 0, 0); __builtin_amdgcn_s_setprio(0); } while (0)
#define PG8_WAIT_V(n) asm volatile("s_waitcnt vmcnt(" #n ")" ::: "memory")
#define PG8_WAIT_L(n) asm volatile("s_waitcnt lgkmcnt(" #n ")" ::: "memory")
#define PG8_BAR __builtin_amdgcn_s_barrier()
#define PG8_SCHED __builtin_amdgcn_sched_barrier(0)
    Unit cur, nxt; int ui = 0;
    if (!S.next(0, cur)) return;
    f32x4 acc[2][2][4][2];
#pragma unroll
    for (int a = 0; a < 2; ++a)
#pragma unroll
        for (int b = 0; b < 2; ++b)
#pragma unroll
            for (int m = 0; m < 4; ++m)
#pragma unroll
                for (int n = 0; n < 2; ++n) acc[a][b][m][n] = (f32x4){0.f, 0.f, 0.f, 0.f};
    bf16x8 At[4][2], B0[2][2], B1[2][2];
    const char* cA = (const char*)g.A + (size_t)cur.pm * tstepA; const char* cB = (const char*)g.Bt + (size_t)cur.pn * tstep;
    S.a_ready(cur);
    PG8_STAGE(PG8_SB(0, 0), cB, voffB); PG8_STAGE(PG8_SA(0, 0), cA, voffA); PG8_STAGE(PG8_SB(0, 1), cB + hstep, voffB); PG8_STAGE(PG8_SA(0, 1), cA + hstepA, voffA);
    if (wr == 1) PG8_BAR;
    PG8_WAIT_V(4); PG8_BAR;
    PG8_STAGE(PG8_SB(1, 0), cB + kstep, voffB); PG8_STAGE(PG8_SA(1, 0), cA + kstep, voffA); PG8_STAGE(PG8_SB(1, 1), cB + hstep + kstep, voffB);
    PG8_WAIT_V(6); PG8_BAR;
    PG8_STAMP();
    for (;;) {
        const bool has_next = S.next(ui + 1, nxt);
        const typename Epi::Pre pre = E.prefetch(cur, wr, wc, fr, fq);
        const char* nA = has_next ? (const char*)g.A + (size_t)nxt.pm * tstepA : cA; const char* nB = has_next ? (const char*)g.Bt + (size_t)nxt.pn * tstep : cB;
        for (int t = 0; t < nt; t += 2) {
            const bool last = (t == nt - 2);
            const char* a1 = cA + (size_t)(t + 1) * kstep;
            const char* a2 = last ? nA : cA + (size_t)(t + 2) * kstep; const char* b2 = last ? nB : cB + (size_t)(t + 2) * kstep;
            const char* a3 = a2 + kstep; const char* b3 = b2 + kstep;
            if (last && has_next) S.a_ready(nxt);
            PG8_LDB(B0, 0, 0); PG8_SCHED; PG8_LDA(At, 0, 0); PG8_STAGE(PG8_SA(1, 1), a1 + hstepA, voffA);
            PG8_WAIT_L(8); PG8_BAR; PG8_WAIT_L(0); PG8_MMA(0, 0, At, B0); PG8_BAR; PG8_SCHED;
            PG8_LDB(B1, 0, 1); PG8_STAGE(PG8_SB(0, 0), b2, voffB);
            PG8_BAR; PG8_WAIT_L(0); PG8_MMA(0, 1, At, B1); PG8_BAR;
            PG8_LDA(At, 0, 1); PG8_STAGE(PG8_SA(0, 0), a2, voffA);
            PG8_BAR; PG8_WAIT_L(0); PG8_MMA(1, 0, At, B0); PG8_BAR; PG8_SCHED;
            PG8_STAGE(PG8_SB(0, 1), b2 + hstep, voffB);
            PG8_WAIT_V(6); PG8_BAR; PG8_MMA(1, 1, At, B1); PG8_BAR;
            PG8_LDB(B0, 1, 0); PG8_SCHED; PG8_LDA(At, 1, 0); PG8_STAGE(PG8_SA(0, 1), a2 + hstepA, voffA);
            PG8_WAIT_L(8); PG8_BAR; PG8_WAIT_L(0); PG8_MMA(0, 0, At, B0); PG8_BAR; PG8_SCHED;
            PG8_LDB(B1, 1, 1); PG8_STAGE(PG8_SB(1, 0), b3, voffB);
            PG8_BAR; PG8_WAIT_L(0); PG8_MMA(0, 1, At, B1); PG8_BAR;
            PG8_LDA(At, 1, 1); PG8_STAGE(PG8_SA(1, 0), a3, voffA);
            PG8_BAR; PG8_WAIT_L(0); PG8_MMA(1, 0, At, B0); PG8_BAR; PG8_SCHED;
            PG8_STAGE(PG8_SB(1, 1), b3 + hstep, voffB);
            PG8_WAIT_V(6); PG8_BAR; PG8_MMA(1, 1, At, B1); PG8_BAR;
        }
        PG8_STAMP();
        if constexpr (!Epi::AFTER_DRAIN) { E(acc, cur, wr, wc, fr, fq, pre); S.done(cur); }
        PG8_STAMP();
        if (!has_next) break;
#pragma unroll
        for (int a = 0; a < 2; ++a)
#pragma unroll
            for (int b = 0; b < 2; ++b)
#pragma unroll
                for (int m = 0; m < 4; ++m)
#pragma unroll
                    for (int n = 0; n < 2; ++n) acc[a][b][m][n] = (f32x4){0.f, 0.f, 0.f, 0.f};
        cur = nxt; cA = nA; cB = nB; ++ui;
    }
    PG8_WAIT_V(0);
    if (wr == 0) PG8_BAR;
    PG8_BAR;
    if constexpr (Epi::AFTER_DRAIN) { E.fused(acc, cur, wr, wc, fr, fq, lds, wid, lane); S.done(cur); }
    PG8_STAMP();
    if (STAMP && wid == 0) { stamps[lane] = lane < nts ? (((unsigned long long)(unsigned)ts_hi << 32) | (unsigned)ts_lo) : 0ull;
        if (lane == 62) stamps[62] = rt_entry; if (lane == 63) stamps[63] = (unsigned long long)wall_clock64(); }
#undef PG8_STAMP
#undef PG8_SA
#undef PG8_SB
#undef PG8_STAGE
#undef PG8_LDA
#undef PG8_LDB
#undef PG8_MMA
#undef PG8_WAIT_V
#undef PG8_WAIT_L
#undef PG8_BAR
#undef PG8_SCHED
}
}

DI float vmax2(float a, float b) { float r; asm("v_max_f32 %0, %1, %2" : "=v"(r) : "v"(a), "v"(b)); return r; }
DI float xhalf_max(float x) {
  auto r = __builtin_amdgcn_permlane32_swap(__float_as_uint(x), __float_as_uint(x), false, false);
  return vmax2(__uint_as_float(r[0]), __uint_as_float(r[1]));
}

DI uint4 gated_pair(const f32x16& o, int p, float inv, uint4 gt) {
  auto x0 = __builtin_amdgcn_permlane32_swap(gt.x, gt.z, false, false);
  auto x1 = __builtin_amdgcn_permlane32_swap(gt.y, gt.w, false, false);
  const unsigned gax = x0[0], gay = x1[0], gbx = x0[1], gby = x1[1];
  const int ia = 8 * p, ib = 8 * p + 4;
  const unsigned wa0 = pack2(o[ia] * inv * bflo(gax), o[ia + 1] * inv * bfhi(gax)), wa1 = pack2(o[ia + 2] * inv * bflo(gay), o[ia + 3] * inv * bfhi(gay));
  const unsigned wb0 = pack2(o[ib] * inv * bflo(gbx), o[ib + 1] * inv * bfhi(gbx)), wb1 = pack2(o[ib + 2] * inv * bflo(gby), o[ib + 3] * inv * bfhi(gby));
  auto y0 = __builtin_amdgcn_permlane32_swap(wa0, wb0, false, false);
  auto y1 = __builtin_amdgcn_permlane32_swap(wa1, wb1, false, false);
  return make_uint4(y0[0], y1[0], y0[1], y1[1]);
}

constexpr int ATT_STAGE = 13312 + 8192;
constexpr float ATT_BIG = 1099511627776.f;
constexpr float ATT_TINY = 8.67361738e-19f;
template <int NKS, int SUBS>
DI void dense_attn_block(int tid, char* lds, const u16* __restrict__ qbase, int q_ld, const u16* __restrict__ kbase, int k_ld,
                         const u16* __restrict__ vt, int nkeys, const u16* __restrict__ gbase, int g_ld, u16* __restrict__ obase, int o_ld) {
  typedef __attribute__((address_space(3))) char lchar;
  typedef const __attribute__((address_space(3))) bf16x8* lfrag;
  constexpr int KPITCH = NKS * 32 + 16;
  constexpr int CPR = NKS * 2;
  constexpr int NKI = (64 * KPITCH) / 1024;
  lchar* L = (lchar*)lds;
  const int lane = tid & 63, wave = __builtin_amdgcn_readfirstlane(tid >> 6), l31 = lane & 31, h = lane >> 5;
  bf16x8 qf[SUBS][NKS];
#pragma unroll
  for (int sub = 0; sub < SUBS; ++sub)
#pragma unroll
    for (int s = 0; s < NKS; ++s) qf[sub][s] = as_frag(ldg16(qbase + (size_t)(wave * 32 * SUBS + sub * 32 + l31) * q_ld + 16 * s + 8 * h));
  f32x16 o[SUBS][2];
  float m[SUBS], l[SUBS];
  bool shifted[SUBS], fresh[SUBS];
#pragma unroll
  for (int sub = 0; sub < SUBS; ++sub) { shifted[sub] = false; fresh[sub] = true; }
#pragma unroll
  for (int sub = 0; sub < SUBS; ++sub) {
    m[sub] = 0.f; l[sub] = 0.f;
#pragma unroll
    for (int dt = 0; dt < 2; ++dt)
#pragma unroll
      for (int r = 0; r < 16; ++r) o[sub][dt][r] = 0.f;
  }
  unsigned koff[2], voff;
#pragma unroll
  for (int i = 0; i < 2; ++i) {
    const unsigned off = (wave + 8 * i) * 1024 + lane * 16;
    const unsigned row = off / KPITCH, c = (off - row * KPITCH) >> 4;
    koff[i] = row * k_ld + (c < (unsigned)CPR ? c : 0u) * 8;
  }
  {
    const unsigned off = wave * 1024 + lane * 16;
    const unsigned row = off >> 7, c = ((off >> 4) & 7) ^ ((row >> 1) & 7);
    voff = row * TPB + c * 8;
  }
  const unsigned ka0 = kappa(l31) * KPITCH + h * 16;
  const unsigned va0 = 13312 + l31 * 128;
  const int swz = (l31 >> 1) & 7;
  const int NT = nkeys >> 6;
#define ATT_STAGE_ISSUE(T_, BUF_) do { \
    lchar* sb_ = L + (BUF_) * ATT_STAGE + wave * 1024; \
    const u16* kb_ = kbase + (size_t)(T_) * 64 * k_ld; \
    _Pragma("unroll") for (int i_ = 0; i_ < 2; ++i_) \
      if (wave + 8 * i_ < NKI) __builtin_amdgcn_global_load_lds((const unsigned*)(kb_ + koff[i_]), (__attribute__((address_space(3))) unsigned*)(sb_ + i_ * 8192), 16, 0, 0); \
    __builtin_amdgcn_global_load_lds((const unsigned*)(vt + (T_) * 64 + voff), (__attribute__((address_space(3))) unsigned*)(sb_ + 13312), 16, 0, 0); \
  } while (0)
#define ATT_LOAD_K(DST_, BUF_, KT_) do { _Pragma("unroll") for (int ks_ = 0; ks_ < NKS; ++ks_) DST_[ks_] = *(lfrag)((BUF_) + ka0 + (KT_) * 32 * KPITCH + ks_ * 32); } while (0)
#define ATT_LOAD_V(DST_, BUF_, KT_, S2_) do { const unsigned co_ = ((2 * ((KT_) * 2 + (S2_)) + h) ^ swz) << 4; \
    DST_[0] = *(lfrag)((BUF_) + va0 + co_); DST_[1] = *(lfrag)((BUF_) + va0 + 4096 + co_); } while (0)
  __builtin_amdgcn_s_barrier();
  asm volatile("" ::: "memory");
  ATT_STAGE_ISSUE(0, 0);
  if (NT > 1) ATT_STAGE_ISSUE(1, 1);
#pragma unroll
  for (int sub = 0; sub < SUBS; ++sub)
#pragma unroll
    for (int s = 0; s < NKS; ++s) asm volatile("" :: "v"(qf[sub][s]));
  asm volatile("s_waitcnt vmcnt(0)" ::: "memory");
  __builtin_amdgcn_s_barrier();
  asm volatile("" ::: "memory");
  bf16x8 kf[NKS], vf0[2], vf1[2];
  ATT_LOAD_K(kf, L, 0);
  int stc = 0;
  for (int t = 0; t < NT; ++t) {
    const lchar* buf = L + stc * ATT_STAGE;
    const int stn = (stc == 2) ? 0 : stc + 1;
#pragma unroll
    for (int kt = 0; kt < 2; ++kt) {
      f32x16 s[SUBS];
#pragma unroll
      for (int sub = 0; sub < SUBS; ++sub)
#pragma unroll
        for (int r = 0; r < 16; ++r) s[sub][r] = 0.f;
#pragma unroll
      for (int ks = 0; ks < NKS; ++ks)
#pragma unroll
        for (int sub = 0; sub < SUBS; ++sub) s[sub] = MFMA32(kf[ks], qf[sub][ks], s[sub]);
      ATT_LOAD_V(vf0, buf, kt, 0);
      ATT_LOAD_V(vf1, buf, kt, 1);
      __builtin_amdgcn_sched_barrier(0);
      uint4 pw[SUBS][2];
#pragma unroll
      for (int sub = 0; sub < SUBS; ++sub) {
        const float mm = m[sub];
        float sum = 0.f;
        float p[16];
        if (!shifted[sub]) {
#pragma unroll
          for (int r = 0; r < 16; ++r) { p[r] = __builtin_amdgcn_exp2f(s[sub][r]); sum += p[r]; }
        } else {
#pragma unroll
          for (int r = 0; r < 16; ++r) { p[r] = __builtin_amdgcn_exp2f(s[sub][r] - mm); sum += p[r]; }
        }
        const bool was_fresh = fresh[sub];
        fresh[sub] = false;
        if (__any(!(sum <= ATT_BIG) || (was_fresh && !(sum >= ATT_TINY)))) {
          float mx = s[sub][0];
#pragma unroll
          for (int r = 1; r < 16; ++r) mx = fmaxf(mx, s[sub][r]);
          mx = xhalf_max(mx);
          const float mn = was_fresh ? mx : fmaxf(mm, mx);
          const float alpha = was_fresh ? 1.f : __builtin_amdgcn_exp2f(mm - mn);
          m[sub] = mn;
          shifted[sub] = true;
          l[sub] *= alpha;
#pragma unroll
          for (int r = 0; r < 16; ++r) { o[sub][0][r] *= alpha; o[sub][1][r] *= alpha; }
          sum = 0.f;
#pragma unroll
          for (int r = 0; r < 16; ++r) { p[r] = __builtin_amdgcn_exp2f(s[sub][r] - mn); sum += p[r]; }
        }
#pragma unroll
        for (int s2 = 0; s2 < 2; ++s2) {
          uint4 w;
          w.x = pack2(p[8 * s2], p[8 * s2 + 1]); w.y = pack2(p[8 * s2 + 2], p[8 * s2 + 3]);
          w.z = pack2(p[8 * s2 + 4], p[8 * s2 + 5]); w.w = pack2(p[8 * s2 + 6], p[8 * s2 + 7]);
          pw[sub][s2] = w;
        }
        l[sub] += sum;
      }
      __builtin_amdgcn_sched_barrier(0);
#pragma unroll
      for (int sub = 0; sub < SUBS; ++sub) {
        o[sub][0] = MFMA32(vf0[0], as_frag(pw[sub][0]), o[sub][0]);
        o[sub][1] = MFMA32(vf0[1], as_frag(pw[sub][0]), o[sub][1]);
      }
      __builtin_amdgcn_sched_barrier(0);
      if (kt == 0) {
        ATT_LOAD_K(kf, buf, 1);
      } else if (t + 1 < NT) {
        asm volatile("s_waitcnt vmcnt(0)" ::: "memory");
        __builtin_amdgcn_s_barrier();
        asm volatile("" ::: "memory");
        if (t + 2 < NT) ATT_STAGE_ISSUE(t + 2, (stn == 2) ? 0 : stn + 1);
        ATT_LOAD_K(kf, L + stn * ATT_STAGE, 0);
      }
      __builtin_amdgcn_sched_barrier(0);
#pragma unroll
      for (int sub = 0; sub < SUBS; ++sub) {
        o[sub][0] = MFMA32(vf1[0], as_frag(pw[sub][1]), o[sub][0]);
        o[sub][1] = MFMA32(vf1[1], as_frag(pw[sub][1]), o[sub][1]);
      }
    }
    stc = stn;
  }
#undef ATT_STAGE_ISSUE
#undef ATT_LOAD_K
#undef ATT_LOAD_V
#pragma unroll
  for (int sub = 0; sub < SUBS; ++sub) {
    const float lt = l[sub] + __shfl_xor(l[sub], 32);
    const float inv = 1.f / lt;
    const size_t row = (size_t)(wave * 32 * SUBS + sub * 32 + l31);
    uint4 gt[2][2];
#pragma unroll
    for (int dt = 0; dt < 2; ++dt)
#pragma unroll
      for (int p = 0; p < 2; ++p) gt[dt][p] = *reinterpret_cast<const uint4*>(gbase + row * g_ld + dt * 32 + 8 * (2 * p + h));
#pragma unroll
    for (int dt = 0; dt < 2; ++dt)
#pragma unroll
      for (int p = 0; p < 2; ++p)
        *reinterpret_cast<uint4*>(obase + row * o_ld + dt * 32 + 8 * (2 * p + h)) = gated_pair(o[sub][dt], p, inv, gt[dt][p]);
  }
}

constexpr int NA_STAGE = 32768, NA_NSTG = 3;
constexpr int NA_BIAS_OFF = NA_NSTG * NA_STAGE;
typedef __attribute__((address_space(3))) char na_lchar;
typedef const __attribute__((address_space(3))) float* na_lfp;
template <int NS, bool LOCAL>
DI void na_steps(const na_lchar* buf, const int (&ko)[NS], const na_lfp (&bp)[NS], const bf16x8 (&qf)[4], const float (&madd)[16],
                 int kap, int h, int swz, unsigned va0, f32x16& o0, f32x16& o1, float& m, float& l, bool& shifted) {
  typedef const __attribute__((address_space(3))) bf16x8* lfrag;
  bf16x8 kf[NS][4];
  float bv[NS][16];
#pragma unroll
  for (int j = 0; j < NS; ++j) {
    const int krow = ko[j] + kap;
    const na_lchar* kp_ = buf + krow * 128;
    const int ksw = (krow >> 1) & 7;
#pragma unroll
    for (int ks = 0; ks < 4; ++ks) kf[j][ks] = *(lfrag)(kp_ + (((2 * ks + h) ^ ksw) << 4));
  }
  if constexpr (LOCAL) {
#pragma unroll
    for (int j = 0; j < NS; ++j)
#pragma unroll
      for (int r = 0; r < 16; ++r) bv[j][r] = bp[j][(r & 7) + 16 * (r >> 3)];
  }
  __builtin_amdgcn_sched_barrier(0);
  f32x16 s[NS];
#pragma unroll
  for (int j = 0; j < NS; ++j)
#pragma unroll
    for (int r = 0; r < 16; ++r) s[j][r] = 0.f;
#pragma unroll
  for (int ks = 0; ks < 4; ++ks)
#pragma unroll
    for (int j = 0; j < NS; ++j) s[j] = MFMA32(kf[j][ks], qf[ks], s[j]);
  bf16x8 vv[NS][2][2];
#pragma unroll
  for (int j = 0; j < NS; ++j)
#pragma unroll
    for (int s2 = 0; s2 < 2; ++s2) {
      const unsigned co = (((ko[j] >> 3) + 2 * s2 + h) ^ swz) << 4;
      vv[j][s2][0] = *(lfrag)(buf + va0 + co);
      vv[j][s2][1] = *(lfrag)(buf + va0 + 8192 + co);
    }
  __builtin_amdgcn_sched_barrier(0);
  uint4 pw[NS][2];
#pragma unroll
  for (int j = 0; j < NS; ++j) {
    if constexpr (LOCAL) {
#pragma unroll
      for (int r = 0; r < 16; ++r) s[j][r] = fminf(s[j][r] + bv[j][r], madd[r]);
    }
    float p[16]; float sum = 0.f;
    if (!shifted) {
#pragma unroll
      for (int r = 0; r < 16; ++r) { p[r] = __builtin_amdgcn_exp2f(s[j][r]); sum += p[r]; }
    } else {
#pragma unroll
      for (int r = 0; r < 16; ++r) { p[r] = __builtin_amdgcn_exp2f(s[j][r] - m); sum += p[r]; }
    }
    if (__any(!(sum <= ATT_BIG) || (l == 0.f && !(sum >= ATT_TINY)))) {
      float mx = s[j][0];
#pragma unroll
      for (int r = 1; r < 16; ++r) mx = fmaxf(mx, s[j][r]);
      mx = xhalf_max(mx);
      const bool empty = (l == 0.f);
      const float mn = empty ? mx : fmaxf(m, mx);
      const float alpha = empty ? 1.f : __builtin_amdgcn_exp2f(m - mn);
      m = mn; shifted = true; l *= alpha;
#pragma unroll
      for (int r = 0; r < 16; ++r) { o0[r] *= alpha; o1[r] *= alpha; }
      sum = 0.f;
#pragma unroll
      for (int r = 0; r < 16; ++r) { p[r] = __builtin_amdgcn_exp2f(s[j][r] - mn); sum += p[r]; }
    }
    l += sum;
#pragma unroll
    for (int s2 = 0; s2 < 2; ++s2) {
      pw[j][s2].x = pack2(p[8 * s2], p[8 * s2 + 1]); pw[j][s2].y = pack2(p[8 * s2 + 2], p[8 * s2 + 3]);
      pw[j][s2].z = pack2(p[8 * s2 + 4], p[8 * s2 + 5]); pw[j][s2].w = pack2(p[8 * s2 + 6], p[8 * s2 + 7]);
    }
  }
  __builtin_amdgcn_sched_barrier(0);
#pragma unroll
  for (int j = 0; j < NS; ++j)
#pragma unroll
    for (int s2 = 0; s2 < 2; ++s2) {
      o0 = MFMA32(vv[j][s2][0], as_frag(pw[j][s2]), o0);
      o1 = MFMA32(vv[j][s2][1], as_frag(pw[j][s2]), o1);
    }
}

DI void na_wait_vm(int n) {
  if (n >= 12) asm volatile("s_waitcnt vmcnt(12) lgkmcnt(0)" ::: "memory");
  else if (n >= 8) asm volatile("s_waitcnt vmcnt(8) lgkmcnt(0)" ::: "memory");
  else if (n >= 4) asm volatile("s_waitcnt vmcnt(4) lgkmcnt(0)" ::: "memory");
  else asm volatile("s_waitcnt vmcnt(0) lgkmcnt(0)" ::: "memory");
}
DI void na_stream(int tid, const Params& P, char* lds, int layer, int hh, int rp2, int b0, int bstep, int nu) {
  const int lane = tid & 63, wave = __builtin_amdgcn_readfirstlane(tid >> 6), l31 = lane & 31, h = lane >> 5;
  const int rp = rp2 * 2 + (wave >> 2), j = wave & 3;
  const int qrow = 2 * rp + (l31 >> 4), qcol = 16 * j + (l31 & 15);
  const unsigned ustride = (unsigned)bstep * TPB;
  unsigned T = (unsigned)b0 * TPB + qrow * 64 + qcol;
  const u16* kbase = reinterpret_cast<const u16*>(P.ws + WS_KNA) + (size_t)b0 * TPB * 512 + hh * 64;
  const u16* vt = reinterpret_cast<const u16*>(P.ws + WS_VTNA) + ((size_t)b0 * 8 + hh) * 64 * TPB;
  const size_t kstride = (size_t)ustride * 512, vstride = (size_t)bstep * 8 * 64 * TPB;
  const u16* qbase = reinterpret_cast<const u16*>(P.ws + WS_QNA) + hh * 64;
  na_lchar* L = (na_lchar*)lds;
  __attribute__((address_space(3))) float* bias = (__attribute__((address_space(3))) float*)(L + NA_BIAS_OFF);
  const int rs_q = min(max(qrow - 4, 0), 24), qcs = min(max(qcol - 8, 0), 48);
  const int rsA = min(max(2 * rp - 4, 0), 24), rsB = min(max(2 * rp - 3, 0), 24);
  const int nrows = 8 + rsB - rsA;
  const int R0 = min(max(4 * rp2 - 4, 0), 24), R1 = min(max(4 * rp2 - 1, 0), 24) + 7;
  const int cb = (j == 0) ? 0 : (j == 1 ? 8 : (j == 2 ? 24 : 32));
  float madd[16];
#pragma unroll
  for (int r = 0; r < 16; ++r) { const int kc = cb + (r & 7) + 8 * h + 16 * (r >> 3); madd[r] = ((kc >= qcs) && (kc < qcs + 16)) ? __builtin_inff() : -1e30f; }
  unsigned koff[2], voff[2];
#pragma unroll
  for (int i = 0; i < 2; ++i) {
    const unsigned off = (wave + 8 * i) * 1024 + lane * 16;
    { const unsigned row = off >> 7, c = ((off >> 4) & 7) ^ ((row >> 1) & 7); koff[i] = row * 512 + c * 8; }
    { const unsigned d = off >> 8, c = ((off >> 4) & 15) ^ ((d >> 1) & 7); voff[i] = d * TPB + c * 8; }
  }
  const int kap = kappa(l31);
  const unsigned va0 = 16384 + l31 * 256;
  const int swz = (l31 >> 1) & 7;
  const int NT = 2 + ((R1 - R0 + 2) >> 1);
  __builtin_amdgcn_s_barrier();
  {
    int ti = tid; asm volatile("" : "+v"(ti));
    const float* rp = P.rpb + ((size_t)layer * 8 + hh) * 465;
    for (int i = ti; i < 15 * 31; i += NTHREADS) bias[i] = rp[(unsigned)i] * LOG2E;
    if (ti < 32) bias[480 + ti] = -1e30f;
  }
#define NA_TOK(T_) ((T_) < 2 ? SEQ + 128 * (T_) : (R0 + 2 * ((T_) - 2)) * 64)
#define NA_ISSUE(KB_, VT_, T_, SLOT_) do { \
    na_lchar* sb_ = L + (SLOT_) * NA_STAGE + wave * 1024; \
    const int tok_ = NA_TOK(T_); \
    _Pragma("unroll") for (int i_ = 0; i_ < 2; ++i_) \
      __builtin_amdgcn_global_load_lds((const unsigned*)((KB_) + (size_t)tok_ * 512 + koff[i_]), (__attribute__((address_space(3))) unsigned*)(sb_ + i_ * 8192), 16, 0, 0); \
    _Pragma("unroll") for (int i_ = 0; i_ < 2; ++i_) \
      __builtin_amdgcn_global_load_lds((const unsigned*)((VT_) + tok_ + voff[i_]), (__attribute__((address_space(3))) unsigned*)(sb_ + 16384 + i_ * 8192), 16, 0, 0); \
  } while (0)
  bf16x8 qf[4], qn[4];
#pragma unroll
  for (int s = 0; s < 4; ++s) qf[s] = as_frag(ldg16(qbase + (T * 512u + 16 * s + 8 * h)));
  NA_ISSUE(kbase, vt, 0, 0); NA_ISSUE(kbase, vt, 1, 1);
  asm volatile("" :: "v"(qf[0]), "v"(qf[1]), "v"(qf[2]), "v"(qf[3]));
#pragma unroll
  for (int s = 0; s < 4; ++s) qn[s] = qf[s];
  int slot_c = 0, slot_i = 2;
#pragma unroll 1
  for (int k = 0; k < nu; ++k) {
    const bool has_next = k + 1 < nu;
    f32x16 o0, o1;
#pragma unroll
    for (int r = 0; r < 16; ++r) { o0[r] = 0.f; o1[r] = 0.f; }
    float m = 0.f, l = 0.f;
    bool shifted = false;
    uint4 gg[4];
    const u16* gbase_u = reinterpret_cast<const u16*>(P.ws + WS_GNA) + hh * 64;
#pragma unroll 1
    for (int t = 0; t < NT; ++t) {
      const na_lchar* buf = L + slot_c * NA_STAGE;
      na_wait_vm((!has_next && t == NT - 1) ? 0 : (t == 0 && k > 0) ? 8 : (t == 1 && k > 0) ? 12 : 4);
      __builtin_amdgcn_s_barrier();
      asm volatile("" ::: "memory");
      if (t + 2 < NT) { NA_ISSUE(kbase, vt, t + 2, slot_i); slot_i = (slot_i == 2) ? 0 : slot_i + 1; }
      else if (has_next) { NA_ISSUE(kbase + kstride, vt + vstride, t + 2 - NT, slot_i); slot_i = (slot_i == 2) ? 0 : slot_i + 1; }
      if (t == 0) {
#pragma unroll
        for (int dt = 0; dt < 2; ++dt)
#pragma unroll
          for (int p = 0; p < 2; ++p) gg[dt * 2 + p] = *reinterpret_cast<const uint4*>(gbase_u + (T * 512u + dt * 32 + 8 * (2 * p + h)));
      }
      if (t == NT - 4 && has_next) {
#pragma unroll
        for (int s = 0; s < 4; ++s) qn[s] = as_frag(ldg16(qbase + ((T + ustride) * 512u + 16 * s + 8 * h)));
      }
      asm volatile("" ::: "memory");
      slot_c = (slot_c == 2) ? 0 : slot_c + 1;
      if (t < 2) {
#pragma unroll 1
        for (int pr = 0; pr < 4; ++pr) {
          const int ko[1] = {32 * pr};
          const na_lfp bp[1] = {bias};
          na_steps<1, false>(buf, ko, bp, qf, madd, kap, h, swz, va0, o0, o1, m, l, shifted);
        }
      } else {
        const int kr0 = R0 + 2 * (t - 2);
        const na_lfp bcol = bias + (cb - qcol + 15) + 8 * h;
#pragma unroll 1
        for (int rr = 0; rr < 2; ++rr) {
          const int kr = kr0 + rr;
          if ((kr >= rsA) && (kr < rsA + nrows)) {
            const int ko[1] = {64 * rr + cb};
            const bool ok = (kr >= rs_q) && (kr < rs_q + 8);
            const na_lfp bp[1] = {ok ? bcol + (kr - qrow + 7) * 31 : bias + 480};
            na_steps<1, true>(buf, ko, bp, qf, madd, kap, h, swz, va0, o0, o1, m, l, shifted);
          }
        }
      }
    }
#pragma unroll
    for (int s = 0; s < 4; ++s) qf[s] = qn[s];
    {
      const float lt = l + __shfl_xor(l, 32);
      const float inv = 1.f / lt;
      u16* obase_u = reinterpret_cast<u16*>(P.ws + WS_H) + hh * 64;
#pragma unroll
      for (int dt = 0; dt < 2; ++dt)
#pragma unroll
        for (int p = 0; p < 2; ++p)
          *reinterpret_cast<uint4*>(obase_u + (T * 1024u + dt * 32 + 8 * (2 * p + h))) = gated_pair(dt == 0 ? o0 : o1, p, inv, gg[dt * 2 + p]);
    }
    T += ustride; kbase += kstride; vt += vstride;
  }
#undef NA_ISSUE
#undef NA_TOK
}

constexpr int N_MLA_U = NB * 8 * 4;
constexpr int N_NA_U = NB * 8 * 8;
constexpr int N_CTX_U = NB * 8;

template <int PART>
DI void phase_attn(int tid, const Params& P, int layer, char* lds, int bid, int nblk) {
  const u16* QM = reinterpret_cast<const u16*>(P.ws + WS_QMLA);
  const u16* KM = reinterpret_cast<const u16*>(P.ws + WS_KMLA);
  const u16* VM = reinterpret_cast<const u16*>(P.ws + WS_VTMLA);
  const u16* GM = reinterpret_cast<const u16*>(P.ws + WS_GMLA);
  u16* MIX = reinterpret_cast<u16*>(P.ws + WS_H);
  const int vb = ((nblk & 7) == 0) ? (bid & 7) * (nblk >> 3) + (bid >> 3) : bid;
  const int n_main = PART == 0 ? N_NA_U : N_MLA_U;
  const int total = n_main + (layer == 0 ? N_CTX_U : 0);
  int u0 = vb;
  if constexpr (PART == 0) {
    const bool strm = (nblk & 63) == 0;
    const int nu_all = vb < n_main ? (n_main - vb + nblk - 1) / nblk : 0;
    for (int u = vb; u < n_main; u += strm ? n_main : nblk)
      na_stream(tid, P, lds, layer, (u >> 3) & 7, u & 7, u >> 6, strm ? nblk >> 6 : 0, strm ? nu_all : 1);
    u0 = vb + nu_all * nblk;
  }
  unsigned* ctx_ctr = reinterpret_cast<unsigned*>(P.ws + WS_CTL + 14336);
  volatile __attribute__((address_space(3))) unsigned* ctx_slot = (volatile __attribute__((address_space(3))) unsigned*)(lds + LDS_WORK + 16);
  for (int us = u0;;) {
    int u = us;
    if (PART == 1 && us >= n_main) {
      if (layer != 0) break;
      __syncthreads();
      if (tid == 0) *ctx_slot = __hip_atomic_fetch_add(ctx_ctr, 1u, __ATOMIC_RELAXED, __HIP_MEMORY_SCOPE_AGENT);
      __syncthreads();
      const unsigned v = *ctx_slot;
      if (v >= (unsigned)N_CTX_U) break;
      u = n_main + (int)v;
    } else {
      if (us >= (PART == 0 ? n_main : total)) break;
      us += nblk;
    }
    if (u < n_main) {
      if constexpr (PART == 1) {
        const int b = u >> 5, hh = (u >> 2) & 7, qb = u & 3;
        const size_t T0 = (size_t)b * TPB + qb * 512;
        dense_attn_block<6, 2>(tid, lds, QM + T0 * 768 + hh * 96, 768, KM + ((size_t)b * 8 + hh) * TPB * 96, 96, VM + ((size_t)b * 8 + hh) * 64 * TPB, TPB,
                               GM + T0 * 512 + hh * 64, 512, MIX + T0 * 1024 + 512 + hh * 64, 1024);
      }
    } else {
      const int v = u - n_main, b = v >> 3, hh = v & 7;
      const size_t T0 = (size_t)b * TPB + SEQ;
      if constexpr (PART == 1) {
        dense_attn_block<6, 1>(tid, lds, QM + T0 * 768 + hh * 96, 768, KM + (((size_t)b * 8 + hh) * TPB + SEQ) * 96, 96, VM + ((size_t)b * 8 + hh) * 64 * TPB + SEQ, CTX,
                               GM + T0 * 512 + hh * 64, 512, MIX + T0 * 1024 + 512 + hh * 64, 1024);
      }
    }
  }
}
DI void na_ctx_units(int tid, const Params& P, char* lds) {
  u16* MIX = reinterpret_cast<u16*>(P.ws + WS_H);
  unsigned* ctr = reinterpret_cast<unsigned*>(P.ws + WS_CTL + 14340);
  volatile __attribute__((address_space(3))) unsigned* slot = (volatile __attribute__((address_space(3))) unsigned*)(lds + LDS_WORK + 20);
  for (;;) {
    __syncthreads();
    if (tid == 0) *slot = __hip_atomic_fetch_add(ctr, 1u, __ATOMIC_RELAXED, __HIP_MEMORY_SCOPE_AGENT);
    __syncthreads();
    const unsigned v = *slot;
    if (v >= (unsigned)N_CTX_U) break;
    const int b = (int)v >> 3, hh = (int)v & 7;
    const size_t T0 = (size_t)b * TPB + SEQ;
    dense_attn_block<4, 1>(tid, lds, reinterpret_cast<const u16*>(P.ws + WS_QNA) + T0 * 512 + hh * 64, 512,
                           reinterpret_cast<const u16*>(P.ws + WS_KNA) + T0 * 512 + hh * 64, 512,
                           reinterpret_cast<const u16*>(P.ws + WS_VTNA) + ((size_t)b * 8 + hh) * 64 * TPB + SEQ, CTX,
                           reinterpret_cast<const u16*>(P.ws + WS_GNA) + T0 * 512 + hh * 64, 512, MIX + T0 * 1024 + hh * 64, 1024);
  }
}

DI void phase_final(int tid, const Params& P, int bid, int nblk) {
  const int t = tid, lane = t & 63, wave = __builtin_amdgcn_readfirstlane(t >> 6);
  const u16* X2 = reinterpret_cast<const u16*>(P.ws + WS_X2);
  constexpr int RPW = 32;
  float4 G[4];
#pragma unroll
  for (int q = 0; q < 4; ++q) G[q] = *reinterpret_cast<const float4*>(P.final_g + q * 256 + lane * 4);
  for (int gw = bid * NWAVES + wave; gw * RPW < NB * SEQ; gw += nblk * NWAVES) {
    const int row0 = gw * RPW;
    uint2 a[4], an[4];
#pragma unroll
    for (int q = 0; q < 4; ++q) a[q] = *reinterpret_cast<const uint2*>(X2 + (size_t)row0 * 1024 + q * 256 + lane * 4);
#pragma unroll 2
    for (int i = 0; i < RPW; ++i) {
      const int row = row0 + i;
      if (i + 1 < RPW) {
#pragma unroll
        for (int q = 0; q < 4; ++q) an[q] = *reinterpret_cast<const uint2*>(X2 + (size_t)(row + 1) * 1024 + q * 256 + lane * 4);
      }
      float4 v[4];
      float ss = 0.f;
#pragma unroll
      for (int q = 0; q < 4; ++q) {
        v[q] = make_float4(bflo(a[q].x), bfhi(a[q].x), bflo(a[q].y), bfhi(a[q].y));
        ss += v[q].x * v[q].x + v[q].y * v[q].y + v[q].z * v[q].z + v[q].w * v[q].w;
      }
      ss = wave_sum(ss);
      const float rstd = rsqrtf(ss * (1.f / 1024.f) + EPS);
      float* dst = P.out + (size_t)row * 1024;
#pragma unroll
      for (int q = 0; q < 4; ++q)
        *reinterpret_cast<float4*>(dst + q * 256 + lane * 4) = make_float4(v[q].x * rstd * G[q].x, v[q].y * rstd * G[q].y, v[q].z * rstd * G[q].z, v[q].w * rstd * G[q].w);
#pragma unroll
      for (int q = 0; q < 4; ++q) a[q] = an[q];
    }
  }
}

DI void phase_inproj(int tid, const Params& P, int layer, char* lds, int bid, int nblk) {
  pg8::Gemm g{reinterpret_cast<const pg8::bf16_t*>(P.ws + WS_H), reinterpret_cast<const pg8::bf16_t*>(P.ws + WS_WIN) + (size_t)layer * 3072 * 1024, MT, NIN, 1024, 1024};
  pg8::InprojOrder S; S.init(layer == 0 ? MT : NB * SEQ, NIN, nblk, bid); S.skip = layer;
  pg8::EpiInproj E{P.ws};
  pg8::gemm_phase<pg8::EpiInproj, pg8::InprojOrder, false>(tid, (PG8_LAS unsigned char*)lds, g, S, E, nullptr);
}
DI void phase_subproj(int tid, const Params& P, int layer, char* lds, int bid, int nblk) {
  const pg8::bf16_t* A = reinterpret_cast<const pg8::bf16_t*>(P.ws + WS_CQKV);
  pg8::Gemm gq{A, reinterpret_cast<const pg8::bf16_t*>(P.ws + WS_WUQ) + (size_t)layer * 768 * 256, MT, 768, 256, 384};
  pg8::EpiQ Eq{P.ws};
  {
    pg8::LatentOrder S; S.init(layer == 0 ? MT : NB * SEQ, 768, nblk, bid); S.skipctx = layer;
    pg8::gemm_phase<pg8::EpiQ, pg8::LatentOrder, false>(tid, (PG8_LAS unsigned char*)lds, gq, S, Eq, nullptr);
  }
  pg8::Gemm gkv{A + 256, reinterpret_cast<const pg8::bf16_t*>(P.ws + WS_WUKV) + (size_t)layer * 1024 * 128, MT, 1024, 128, 384};
  pg8::EpiKV Ekv{P.ws};
  pg8::StaticOrder S2; S2.init(MT, 1024, nblk, nblk - 1 - bid);
  pg8::gemm_phase<pg8::EpiKV, pg8::StaticOrder, false>(tid, (PG8_LAS unsigned char*)lds, gkv, S2, Ekv, nullptr);
}
DI void phase_outproj(int tid, const Params& P, int layer, char* lds, int bid, int nblk) {
  pg8::Gemm g{reinterpret_cast<const pg8::bf16_t*>(P.ws + WS_H), reinterpret_cast<const pg8::bf16_t*>(P.ws + WS_WOUT) + (size_t)layer * 1024 * 1024, MT, 1024, 1024, 1024};
  pg8::EpiOutproj E{P.x, P.ctx, layer == 0 ? nullptr : reinterpret_cast<const pg8::bf16_t*>(P.out),
                    layer == 0 ? reinterpret_cast<pg8::bf16_t*>(P.out) : reinterpret_cast<pg8::bf16_t*>(P.ws + WS_X2), reinterpret_cast<pg8::bf16_t*>(P.ws + WS_CTX1),
                    reinterpret_cast<const float*>(P.ws + WS_MOD) + (size_t)layer * 33 * 3072};
  {
    pg8::LatentOrder S; S.init(layer == 0 ? MT : NB * SEQ, 1024, nblk, bid); S.skipctx = layer;
    pg8::gemm_phase<pg8::EpiOutproj, pg8::LatentOrder, false>(tid, (PG8_LAS unsigned char*)lds, g, S, E, nullptr);
  }
}

#define XB_TMO      128
#define XB_XCNT(j)  (256  + 64 * (j))
#define XB_XSUB(j)  (1280 + 64 * (j))
#define XB_XGEN(j)  (2304 + 64 * (j))
#define XB_TOP      3328
#define XB_TOPGEN   3392
#define XCD_BAR_WORDS 3456
#define XB_SPIN_CAP (1u << 22)
#define LAS __attribute__((address_space(3)))
DI unsigned xb_ld(unsigned* p)              { return __hip_atomic_load(p, __ATOMIC_RELAXED, __HIP_MEMORY_SCOPE_AGENT); }
DI unsigned xb_add(unsigned* p, unsigned v) { return __hip_atomic_fetch_add(p, v, __ATOMIC_RELAXED, __HIP_MEMORY_SCOPE_AGENT); }
DI unsigned xb_xcc_id() { return (unsigned)__builtin_amdgcn_s_getreg((3 << 11) | 20) & 0xFu; }
#define XB_SPIN(cond, bar) do { unsigned _sp = 0; while (cond) { __builtin_amdgcn_s_sleep(1); \
    if ((++_sp & 255u) == 0u) { if (xb_ld(&(bar)[XB_TMO])) break; if (_sp > XB_SPIN_CAP) { atomicAdd(&(bar)[XB_TMO], 1u); break; } } } } while (0)
struct XcdBarrier { unsigned* bar; unsigned x; volatile LAS unsigned* st; };
DI XcdBarrier xcd_barrier_post(unsigned* bar, volatile LAS unsigned* st, bool leader) {
  XcdBarrier b; b.bar = bar; b.x = xb_xcc_id(); b.st = st;
  if (leader) (void)xb_add(&bar[XB_XCNT(b.x)], 1u);
  return b;
}
DI void xcd_barrier_complete(unsigned* bar, unsigned x, unsigned& nloc, unsigned& nx) {
  const unsigned G = gridDim.x * gridDim.y * gridDim.z;
  unsigned sum, cnt, mine, sp = 0u;
  for (;;) {
    sum = 0u; cnt = 0u; mine = 0u;
#pragma unroll
    for (unsigned j = 0; j < 16; ++j) { const unsigned c = xb_ld(&bar[XB_XCNT(j)]); sum += c; cnt += (c > 0u) ? 1u : 0u; mine = (j == x) ? c : mine; }
    if (sum == G) break;
    __builtin_amdgcn_s_sleep(1);
    if ((++sp & 255u) == 0u) { if (xb_ld(&bar[XB_TMO])) break; if (sp > XB_SPIN_CAP) { atomicAdd(&bar[XB_TMO], 1u); break; } }
  }
  nloc = mine > 0u ? mine : 1u; nx = cnt > 0u ? cnt : 1u;
}
DI void xcd_barrier(const XcdBarrier& b, bool leader) {
  asm volatile("s_waitcnt vmcnt(0)" ::: "memory");
  __syncthreads();
  if (leader) {
    unsigned* bar = b.bar;
    __builtin_amdgcn_s_waitcnt(0);
    unsigned nloc = b.st[0], nx = b.st[1];
    if (nloc == 0u) { xcd_barrier_complete(bar, b.x, nloc, nx); b.st[0] = nloc; b.st[1] = nx; }
    const unsigned old = xb_add(&bar[XB_XSUB(b.x)], 1u);
    const unsigned gen = old / nloc;
    if (old + 1u == (gen + 1u) * nloc) {
      __builtin_amdgcn_fence(__ATOMIC_RELEASE, "agent");
      asm volatile("s_waitcnt vmcnt(0)" ::: "memory");
      const unsigned og = xb_add(&bar[XB_TOP], 1u);
      const unsigned tg = og / nx;
      if (og + 1u == (tg + 1u) * nx) xb_add(&bar[XB_TOPGEN], 1u);
      else XB_SPIN(xb_ld(&bar[XB_TOPGEN]) == tg, bar);
      __builtin_amdgcn_fence(__ATOMIC_ACQUIRE, "agent");
      xb_add(&bar[XB_XGEN(b.x)], 1u);
      asm volatile("s_waitcnt vmcnt(0)" ::: "memory");
    } else {
      XB_SPIN(xb_ld(&bar[XB_XGEN(b.x)]) == gen, bar);
      __builtin_amdgcn_fence(__ATOMIC_ACQUIRE, "agent");
      asm volatile("s_waitcnt vmcnt(0)" ::: "memory");
    }
  }
  __syncthreads();
}

#ifndef ONLY_K
#define ONLY_K -1
#endif
typedef const __attribute__((address_space(4))) unsigned char* kargp_t;
DI Params load_params(kargp_t kp) {
  const __attribute__((address_space(4))) unsigned long long* k8 = reinterpret_cast<const __attribute__((address_space(4))) unsigned long long*>(kp);
#define GP_(T, i) ((T*)(__attribute__((address_space(1))) T*)(k8[i]))
  Params q;
  q.x = GP_(const float, 0); q.c = GP_(const float, 1); q.ctx = GP_(const float, 2); q.c_ctx = GP_(const float, 3); q.norm_g = GP_(const float, 4);
  q.w_ada = GP_(const float, 5); q.b_ada = GP_(const float, 6); q.w_in = GP_(const float, 7); q.rpb = GP_(const float, 8); q.q_norm_g = GP_(const float, 9);
  q.w_uq = GP_(const float, 10); q.kv_norm_g = GP_(const float, 11); q.w_ukv = GP_(const float, 12); q.w_out = GP_(const float, 13); q.final_g = GP_(const float, 14);
  q.out = GP_(float, 15); q.ws = GP_(unsigned char, 16);
#undef GP_
  return q;
}
DI void run_phase(int tid, kargp_t kp, int ph, char* lds, int bid, int nblk) {
  if (ph == 0) { if (ONLY_K < 0 || ONLY_K == 5) { const Params P = load_params(kp); phase0(tid, P, lds, bid, nblk); } return; }
  if (ph == 11) { if (ONLY_K < 0 || ONLY_K == 6) { const Params P = load_params(kp); phase_final(tid, P, bid, nblk); } return; }
  const int layer = (ph - 1) / 5, k = (ph - 1) % 5;
  if (k == 0) { if (ONLY_K < 0 || ONLY_K == 0) { const Params P = load_params(kp); phase_norm(tid, P, layer, bid, nblk); } }
  else if (k == 1) { if (ONLY_K < 0 || ONLY_K == 1) { const Params P = load_params(kp); phase_inproj(tid, P, layer, lds, bid, nblk); } }
  else if (k == 2) { if (ONLY_K < 0 || ONLY_K == 2) { const Params P = load_params(kp); phase_attn<0>(tid, P, layer, lds, bid, nblk); __syncthreads(); phase_subproj(tid, P, layer, lds, bid, nblk); if (layer == 0) na_ctx_units(tid, P, lds); } }
  else if (k == 3) { if (ONLY_K < 0 || ONLY_K == 3) { const Params P = load_params(kp); phase_attn<1>(tid, P, layer, lds, bid, nblk); } }
  else { if (ONLY_K < 0 || ONLY_K == 4) { const Params P = load_params(kp); phase_outproj(tid, P, layer, lds, bid, nblk); } }
}

DI int lane_id_now() { int l; asm volatile("v_mbcnt_lo_u32_b32 %0, -1, 0\n\tv_mbcnt_hi_u32_b32 %0, -1, %0" : "=v"(l)); return l; }

#if !MK_FUSED
__global__ void __launch_bounds__(NTHREADS, 2) k_phase(Params P, int ph) {
  extern __shared__ __attribute__((aligned(16))) char lds[];
  const int tid = threadIdx.x;
  run_phase(tid, (kargp_t)__builtin_amdgcn_kernarg_segment_ptr(), ph, lds, blockIdx.x, gridDim.x);
}
#else
__global__ void __launch_bounds__(NTHREADS, 2) k_mega(Params P) {
  extern __shared__ __attribute__((aligned(16))) char lds[];
  const int wave_s = __builtin_amdgcn_readfirstlane(threadIdx.x >> 6);
#define MY_TID() (wave_s * 64 + lane_id_now())
  volatile LAS unsigned* st = (volatile LAS unsigned*)(lds + LDS_WORK);
  if (MY_TID() == 0) { st[0] = 0u; st[1] = 0u; }
  __syncthreads();
  XcdBarrier bar = xcd_barrier_post(reinterpret_cast<unsigned*>(P.ws + WS_CTL), st, MY_TID() == 0);
#pragma unroll 1
  for (int ph = 0; ph < 12; ++ph) {
    int tid = MY_TID();
    asm volatile("" : "+v"(tid));
    tid &= NTHREADS - 1;
    kargp_t kp = (kargp_t)__builtin_amdgcn_kernarg_segment_ptr();
    asm volatile("" : "+s"(kp));
    run_phase(tid, kp, ph, lds, blockIdx.x, gridDim.x);
    if (ph < 11) xcd_barrier(bar, MY_TID() == 0);
  }
#undef MY_TID
}
#endif

extern "C" void kernel_launch(void* const* d_in, const int* in_sizes, int n_in, void* d_out, int out_size, void* d_ws, size_t ws_size, hipStream_t stream) {
  static int grid_blocks = 0;
  if (!grid_blocks) {
    int dev = 0, cus = 0, per_cu = 0;
    (void)hipGetDevice(&dev);
    (void)hipDeviceGetAttribute(&cus, hipDeviceAttributeMultiprocessorCount, dev);
#if MK_FUSED
    (void)hipFuncSetAttribute((const void*)k_mega, hipFuncAttributeMaxDynamicSharedMemorySize, LDS_BYTES);
    (void)hipOccupancyMaxActiveBlocksPerMultiprocessor(&per_cu, (const void*)k_mega, NTHREADS, LDS_BYTES);
#else
    (void)hipFuncSetAttribute((const void*)k_phase, hipFuncAttributeMaxDynamicSharedMemorySize, LDS_BYTES);
    (void)hipOccupancyMaxActiveBlocksPerMultiprocessor(&per_cu, (const void*)k_phase, NTHREADS, LDS_BYTES);
#endif
    if (per_cu > 1) per_cu = 1;
    if (per_cu < 1) per_cu = 1;
    grid_blocks = cus * per_cu;
  }
  Params p{};
  p.x = (const float*)d_in[0]; p.c = (const float*)d_in[1]; p.ctx = (const float*)d_in[2]; p.c_ctx = (const float*)d_in[3];
  p.norm_g = (const float*)d_in[4]; p.w_ada = (const float*)d_in[5]; p.b_ada = (const float*)d_in[6]; p.w_in = (const float*)d_in[7];
  p.rpb = (const float*)d_in[8]; p.q_norm_g = (const float*)d_in[9]; p.w_uq = (const float*)d_in[10]; p.kv_norm_g = (const float*)d_in[11];
  p.w_ukv = (const float*)d_in[12]; p.w_out = (const float*)d_in[13]; p.final_g = (const float*)d_in[14];
  p.out = (float*)d_out; p.ws = (unsigned char*)d_ws;
#if MK_FUSED
  (void)hipMemsetAsync((char*)d_ws + WS_CTL, 0, 16384, stream);
  void* args[] = {&p};
  hipError_t e = hipLaunchCooperativeKernel((const void*)k_mega, dim3(grid_blocks), dim3(NTHREADS), args, LDS_BYTES, stream);
  if (e != hipSuccess) fprintf(stderr, "cooperative launch failed: %s (grid %d)\n", hipGetErrorString(e), grid_blocks);
#else
  for (int ph = 0; ph < 12; ++ph) hipLaunchKernelGGL(k_phase, dim3(grid_blocks), dim3(NTHREADS), LDS_BYTES, stream, p, ph);
#endif
}
```
